# Optimizing an MI355X kernel written in HIP

```python
import math
import jax
import jax.numpy as jnp
from jax import lax
import numpy as np

D_MODEL = 2048
BATCH = 4
SEQ = 4096
DEPTH = 4

HEAD_DIM = 128
GRID_W = 64
ROPE_THETA = 10000.0
EPS = 1e-6
NEG_INF = -1e30

A_HEADS = 6
A_PATTERNS = ((128, 1), (512, 4), (2048, 16))
A_BAND_BLOCK = 64
B_Q_HEADS = 8
B_KV_HEADS = 2
B_Q_BLOCK = 128
C_HEADS = 8
C_QK_DIM = 64
C_V_DIM = 128
C_CHUNK = 64
C_CONV = 5
D_FF = 4 * D_MODEL
N_BRANCHES = 3

A_WIDTH = A_HEADS * HEAD_DIM
B_Q_WIDTH = B_Q_HEADS * HEAD_DIM
B_KV_WIDTH = B_KV_HEADS * HEAD_DIM
C_QK_WIDTH = C_HEADS * C_QK_DIM
C_V_WIDTH = C_HEADS * C_V_DIM
C_GATES = 4 * C_HEADS
IN_SPLITS = (A_WIDTH, A_WIDTH, A_WIDTH, B_Q_WIDTH, B_KV_WIDTH, B_KV_WIDTH, 2 * C_QK_WIDTH, C_V_WIDTH, C_V_WIDTH, C_GATES, N_BRANCHES * D_MODEL)
IN_COLS = sum(IN_SPLITS)

kernel_name = 'hybrid_dilated_gqa_mlstm_encoder'


def rms_norm(x, g):
    xf = x.astype(jnp.float32)
    y = xf * lax.rsqrt(jnp.mean(xf * xf, axis=-1, keepdims=True) + EPS)
    return (y * g.astype(jnp.float32)).astype(x.dtype)


def rope_tables(pos, dim, dtype):
    inv_freq = ROPE_THETA ** (-jnp.arange(0, dim, 2, dtype=jnp.float32) / dim)
    ang = pos.astype(jnp.float32)[:, None] * inv_freq[None, :]
    return jnp.cos(ang).astype(dtype), jnp.sin(ang).astype(dtype)


def apply_rope(x, cos, sin):
    half = x.shape[-1] // 2
    x1, x2 = x[..., :half], x[..., half:]
    c, s = cos[None, :, None, :], sin[None, :, None, :]
    return jnp.concatenate([x1 * c - x2 * s, x2 * c + x1 * s], axis=-1)


def dilated_band_attention(q, k, v, dilation, reach):
    bsz, seq, heads, hd = q.shape
    L = seq // dilation
    blk = A_BAND_BLOCK
    nb = -(-L // blk)
    Lp = nb * blk

    def by_residue(t):
        return t.reshape(bsz, L, dilation, heads, hd).transpose(0, 2, 3, 1, 4)

    qr, kr, vr = by_residue(q), by_residue(k), by_residue(v)
    qb = jnp.pad(qr, ((0, 0), (0, 0), (0, 0), (0, Lp - L), (0, 0))).reshape(bsz, dilation, heads, nb, blk, hd)
    pad_k = ((0, 0), (0, 0), (0, 0), (blk, Lp - L + blk), (0, 0))

    def band(t):
        tb = jnp.pad(t, pad_k).reshape(bsz, dilation, heads, nb + 2, blk, hd)
        return jnp.concatenate([tb[:, :, :, :-2], tb[:, :, :, 1:-1], tb[:, :, :, 2:]], axis=4)

    kw, vw = band(kr), band(vr)
    qpos = jnp.arange(nb)[:, None, None] * blk + jnp.arange(blk)[None, :, None]
    kpos = jnp.arange(nb)[:, None, None] * blk + jnp.arange(3 * blk)[None, None, :] - blk
    valid = (jnp.abs(kpos - qpos) <= reach) & (kpos >= 0) & (kpos < L)
    s = jnp.einsum('bdhiqc,bdhikc->bdhiqk', qb, kw).astype(jnp.float32) * (hd ** -0.5)
    s = jnp.where(valid, s, NEG_INF)
    m = jnp.max(s, axis=-1, keepdims=True)
    p = jnp.exp(s - m)
    z = jnp.sum(p, axis=-1, keepdims=True)
    o = jnp.einsum('bdhiqk,bdhikc->bdhiqc', (p / z).astype(v.dtype), vw)
    lse = (m + jnp.log(z))[..., 0]
    o = o.reshape(bsz, dilation, heads, Lp, hd)[:, :, :, :L].transpose(0, 3, 1, 2, 4).reshape(bsz, seq, heads, hd)
    lse = lse.reshape(bsz, dilation, heads, Lp)[:, :, :, :L].transpose(0, 3, 1, 2).reshape(bsz, seq, heads)
    return o, lse


def dilated_mixer(q, k, v, q_gain, k_gain, rope_1d):
    bsz, seq, _ = q.shape
    shp = (bsz, seq, A_HEADS, HEAD_DIM)
    cos, sin = rope_1d
    q = apply_rope(rms_norm(q.reshape(shp), q_gain), cos, sin)
    k = apply_rope(rms_norm(k.reshape(shp), k_gain), cos, sin)
    v = v.reshape(shp)
    outs, lses = [], []
    for window, dilation in A_PATTERNS:
        o, lse = dilated_band_attention(q, k, v, dilation, window // (2 * dilation))
        outs.append(o)
        lses.append(lse)
    w = jax.nn.softmax(jnp.stack(lses), axis=0)
    o = jnp.einsum('gbsh,gbshc->bshc', w, jnp.stack(outs).astype(jnp.float32))
    return o.astype(v.dtype).reshape(bsz, seq, A_WIDTH)


def gqa_axial_mixer(q, k, v, q_gain, k_gain, rope_row, rope_col):
    bsz, seq, _ = q.shape
    half = HEAD_DIM // 2
    group = B_Q_HEADS // B_KV_HEADS

    def axial(t):
        return jnp.concatenate([apply_rope(t[..., :half], *rope_row), apply_rope(t[..., half:], *rope_col)], axis=-1)

    q = axial(rms_norm(q.reshape(bsz, seq, B_Q_HEADS, HEAD_DIM), q_gain))
    k = axial(rms_norm(k.reshape(bsz, seq, B_KV_HEADS, HEAD_DIM), k_gain))
    v = v.reshape(bsz, seq, B_KV_HEADS, HEAD_DIM)
    nb = seq // B_Q_BLOCK
    qb = q.reshape(bsz, nb, B_Q_BLOCK, B_KV_HEADS, group, HEAD_DIM).transpose(1, 0, 3, 4, 2, 5)
    scale = HEAD_DIM ** -0.5

    def attend(q_blk):
        s = jnp.einsum('bhgqc,bkhc->bhgqk', q_blk, k).astype(jnp.float32) * scale
        p = jax.nn.softmax(s, axis=-1).astype(v.dtype)
        return jnp.einsum('bhgqk,bkhc->bhgqc', p, v)

    o = lax.map(attend, qb)
    return o.transpose(1, 0, 4, 2, 3, 5).reshape(bsz, seq, B_Q_WIDTH)


def centred_depthwise_conv(x, w, b):
    chans = x.shape[-1]
    pad = C_CONV // 2
    y = lax.conv_general_dilated(x, w[:, None, :], window_strides=(1,), padding=[(pad, pad)],
                                 dimension_numbers=('NWC', 'WIO', 'NWC'), feature_group_count=chans)
    return y + b


def mlstm_chunkwise(q, k, v, log_f, log_i):
    bsz, heads, seq, dqk = q.shape
    dv = v.shape[-1]
    L = C_CHUNK
    nc = seq // L

    def chunks(t):
        return jnp.moveaxis(t.reshape(bsz, heads, nc, L, *t.shape[3:]), 2, 0)

    tril = jnp.tril(jnp.ones((L, L), dtype=bool))

    def step(carry, inp):
        C, n, m = carry
        qc, kc, vc, lf, ic = inp
        b = jnp.cumsum(lf, axis=-1)
        D = jnp.where(tril, b[..., :, None] - b[..., None, :] + ic[..., None, :], NEG_INF)
        m_inter = b + m[..., None]
        m_t = jnp.maximum(m_inter, jnp.max(D, axis=-1))
        A = jnp.exp(D - m_t[..., None]) * jnp.einsum('bhtd,bhsd->bhts', qc, kc)
        inter = jnp.exp(m_inter - m_t)
        num = jnp.einsum('bhts,bhsv->bhtv', A, vc) + inter[..., None] * jnp.einsum('bhvd,bhtd->bhtv', C, qc)
        den = jnp.sum(A, axis=-1) + inter * jnp.einsum('bhd,bhtd->bht', n, qc)
        h = num / jnp.maximum(jnp.abs(den), jnp.exp(-m_t))[..., None]
        b_last = b[..., -1]
        g = b_last[..., None] - b + ic
        m_new = jnp.maximum(b_last + m, jnp.max(g, axis=-1))
        decay = jnp.exp(b_last + m - m_new)
        wk = jnp.exp(g - m_new[..., None])
        C_new = decay[..., None, None] * C + jnp.einsum('bhsv,bhsd->bhvd', vc * wk[..., None], kc)
        n_new = decay[..., None] * n + jnp.einsum('bhs,bhsd->bhd', wk, kc)
        return (C_new, n_new, m_new), h

    init = (jnp.zeros((bsz, heads, dv, dqk), jnp.float32), jnp.zeros((bsz, heads, dqk), jnp.float32),
            jnp.zeros((bsz, heads), jnp.float32))
    _, h = lax.scan(step, init, (chunks(q), chunks(k), chunks(v), chunks(log_f), chunks(log_i)))
    return jnp.moveaxis(h, 0, 2).reshape(bsz, heads, seq, dv)


def mlstm_mixer(qk_pre, v, o_pre, gate_pre, conv_w, conv_b, gate_b, out_g):
    bsz, seq, _ = qk_pre.shape
    qk = jax.nn.silu(centred_depthwise_conv(qk_pre, conv_w, conv_b))
    to_heads = lambda t, d: t.reshape(bsz, seq, C_HEADS, d).transpose(0, 2, 1, 3).astype(jnp.float32)
    q = to_heads(qk[..., :C_QK_WIDTH], C_QK_DIM)
    k = to_heads(qk[..., C_QK_WIDTH:], C_QK_DIM) * (C_QK_DIM ** -0.5)
    vh = to_heads(v, C_V_DIM)
    gates = (gate_pre + gate_b).astype(jnp.float32).reshape(bsz, seq, 4, C_HEADS).transpose(2, 0, 3, 1)
    i_fw, f_fw, i_bw, f_bw = gates[0], gates[1], gates[2], gates[3]
    h_fw = mlstm_chunkwise(q, k, vh, jax.nn.log_sigmoid(f_fw), i_fw)
    flip = lambda t: jnp.flip(t, axis=2)
    h_bw = flip(mlstm_chunkwise(flip(q), flip(k), flip(vh), jax.nn.log_sigmoid(flip(f_bw)), flip(i_bw)))
    h = (h_fw + h_bw).transpose(0, 2, 1, 3)
    h = h * lax.rsqrt(jnp.mean(h * h, axis=-1, keepdims=True) + EPS)
    h = h.reshape(bsz, seq, C_V_WIDTH) * out_g.astype(jnp.float32)
    return (h * jax.nn.sigmoid(o_pre.astype(jnp.float32))).astype(qk_pre.dtype)


def hybrid_layer(x, rope_1d, rope_row, rope_col, norm1_g, w_in, a_q_gain, a_k_gain, b_q_gain, b_k_gain,
                 c_conv_w, c_conv_b, c_gate_b, c_out_g, w_branch_a, w_branch_b, w_branch_c, w_out,
                 norm2_g, w_up, w_down):
    bsz, seq, _ = x.shape
    xn = rms_norm(x, norm1_g)
    split_points = [int(p) for p in np.cumsum(IN_SPLITS)[:-1]]
    (a_q, a_k, a_v, b_q, b_k, b_v, c_qk, c_v, c_o, c_gate, g) = jnp.split(xn @ w_in, split_points, axis=-1)
    ya = dilated_mixer(a_q, a_k, a_v, a_q_gain, a_k_gain, rope_1d)
    yb = gqa_axial_mixer(b_q, b_k, b_v, b_q_gain, b_k_gain, rope_row, rope_col)
    yc = mlstm_mixer(c_qk, c_v, c_o, c_gate, c_conv_w, c_conv_b, c_gate_b, c_out_g)
    gates = jax.nn.sigmoid(g.astype(jnp.float32)).astype(x.dtype).reshape(bsz, seq, N_BRANCHES, D_MODEL)
    merged = (gates[:, :, 0] * (ya @ w_branch_a) + gates[:, :, 1] * (yb @ w_branch_b)
              + gates[:, :, 2] * (yc @ w_branch_c))
    h = x + merged @ w_out
    u = jnp.maximum(rms_norm(h, norm2_g) @ w_up, 0)
    return h + (u * u) @ w_down


def setup_inputs(seed: int = 0) -> dict:
    key = jax.random.key(seed)
    ks = jax.random.split(key, 20)
    f32 = jnp.float32
    nrm = lambda k, shape, fan_in: jax.random.normal(k, shape, f32) * (fan_in ** -0.5)
    gain = lambda k, shape: 1.0 + 0.02 * jax.random.normal(k, shape, f32)
    f_base = jnp.linspace(3.0, 6.0, C_HEADS, dtype=f32)
    i_base = jnp.zeros((C_HEADS,), f32)
    gate_base = jnp.concatenate([i_base, f_base, i_base, f_base])
    return {
        'x': jax.random.normal(ks[0], (BATCH, SEQ, D_MODEL), f32),
        'norm1_g': gain(ks[1], (DEPTH, D_MODEL)),
        'w_in': nrm(ks[2], (DEPTH, D_MODEL, IN_COLS), D_MODEL),
        'a_q_gain': gain(ks[3], (DEPTH, HEAD_DIM)),
        'a_k_gain': gain(ks[4], (DEPTH, HEAD_DIM)),
        'b_q_gain': gain(ks[5], (DEPTH, HEAD_DIM)),
        'b_k_gain': gain(ks[6], (DEPTH, HEAD_DIM)),
        'c_conv_w': nrm(ks[7], (DEPTH, C_CONV, 2 * C_QK_WIDTH), C_CONV),
        'c_conv_b': 0.02 * jax.random.normal(ks[8], (DEPTH, 2 * C_QK_WIDTH), f32),
        'c_gate_b': gate_base[None, :] + 0.1 * jax.random.normal(ks[9], (DEPTH, C_GATES), f32),
        'c_out_g': gain(ks[10], (DEPTH, C_V_WIDTH)),
        'w_branch_a': nrm(ks[11], (DEPTH, A_WIDTH, D_MODEL), A_WIDTH),
        'w_branch_b': nrm(ks[12], (DEPTH, B_Q_WIDTH, D_MODEL), B_Q_WIDTH),
        'w_branch_c': nrm(ks[13], (DEPTH, C_V_WIDTH, D_MODEL), C_V_WIDTH),
        'w_out': nrm(ks[14], (DEPTH, D_MODEL, D_MODEL), D_MODEL),
        'norm2_g': gain(ks[15], (DEPTH, D_MODEL)),
        'w_up': nrm(ks[16], (DEPTH, D_MODEL, D_FF), D_MODEL),
        'w_down': nrm(ks[17], (DEPTH, D_FF, D_MODEL), D_FF),
    }


def reference(x, norm1_g, w_in, a_q_gain, a_k_gain, b_q_gain, b_k_gain, c_conv_w, c_conv_b, c_gate_b,
              c_out_g, w_branch_a, w_branch_b, w_branch_c, w_out, norm2_g, w_up, w_down):
    seq = x.shape[1]
    rows = seq // GRID_W
    pos = jnp.arange(seq)
    row = jnp.repeat(jnp.arange(rows), GRID_W)
    col = jnp.tile(jnp.arange(GRID_W), rows)
    rope_1d = rope_tables(pos, HEAD_DIM, x.dtype)
    rope_row = rope_tables(row, HEAD_DIM // 2, x.dtype)
    rope_col = rope_tables(col, HEAD_DIM // 2, x.dtype)
    for l in range(DEPTH):
        x = hybrid_layer(x, rope_1d, rope_row, rope_col, norm1_g[l], w_in[l], a_q_gain[l], a_k_gain[l],
                         b_q_gain[l], b_k_gain[l], c_conv_w[l], c_conv_b[l], c_gate_b[l], c_out_g[l],
                         w_branch_a[l], w_branch_b[l], w_branch_c[l], w_out[l], norm2_g[l], w_up[l], w_down[l])
    return x
```

```cpp
#include <hip/hip_runtime.h>
#include <cstdio>
#include <cstdint>

__device__ __forceinline__ int tid_l() { int t = (int)threadIdx.x; asm volatile("" : "+v"(t)); return t; }
namespace pg8 {
#define PG8_LAS __attribute__((address_space(3)))
typedef unsigned short bf16_t;
typedef short bf16x8 __attribute__((ext_vector_type(8)));
typedef float f32x4 __attribute__((ext_vector_type(4)));
typedef unsigned u32x4 __attribute__((ext_vector_type(4)));
constexpr int BM = 256, BK = 64, HALF = 128, HTB = HALF * BK * 2  , STAGE_BYTES = 8 * HTB, NXCD = 8, WGM = 4;

__host__ __device__ __forceinline__ int lds_byte(int r, int c) { const int st = (r >> 4) * 2 + (c >> 5), rr = r & 15, cc = c & 31, ob = rr * 64 + cc * 2; return st * 1024 + (ob ^ (((ob >> 9) & 1) << 5)); }
__host__ __device__ __forceinline__ void stage_rc(int b, int& R, int& C) { const int st = b / 1024, sb = b % 1024, swz = sb ^ (((sb >> 9) & 1) << 5); R = (st >> 1) * 16 + swz / 64; C = (st & 1) * 32 + (swz % 64) / 2; }
__host__ __device__ __forceinline__ int perm32(int rho) { const int n = rho >> 4, i = rho & 15; return 8 * (i >> 2) + 4 * n + (i & 3); }

struct Unit { int pm, pn; };
struct Gemm { const bf16_t* A; const bf16_t* Bt; int M, N, K, pad_; };

struct StaticOrder {
    int nM, nN, nwg, G, c, wgm;
    __host__ __device__ void init(int M, int N, int G_, int c_, int wgm_ = WGM) { nM = M / BM; nN = N / BM; nwg = nM * nN; G = G_; c = c_; wgm = wgm_; }
    __host__ __device__ bool next(int i, Unit& u) const {
        const long L = (long)i * G + c; if (L >= nwg) return false;
        int wgid = (int)L; { const int q = nwg / NXCD, r = nwg % NXCD, xcd = wgid % NXCD, off = wgid / NXCD; wgid = (xcd < r ? xcd * (q + 1) : r * (q + 1) + (xcd - r) * q) + off; }
        const int nig = wgm * nN, gid = wgid / nig, fm = gid * wgm, gsz = (nM - fm) < wgm ? (nM - fm) : wgm;
        u.pm = fm + ((wgid % nig) % gsz); u.pn = (wgid % nig) / gsz; return true;
    }
    __device__ __forceinline__ void a_ready(const Unit&) const {}
    __device__ __forceinline__ void done(const Unit&) const {}
};
__device__ __forceinline__ unsigned cvt_pk_bf16(float lo, float hi) { unsigned r; asm volatile("v_cvt_pk_bf16_f32 %0, %1, %2" : "=v"(r) : "v"(lo), "v"(hi)); return r; }
typedef _Float16 f16x2_t __attribute__((ext_vector_type(2)));
typedef _Float16 f16x8_t __attribute__((ext_vector_type(8)));
__device__ __forceinline__ unsigned cvt_pk_f16(float lo, float hi) { const f16x2_t h = {(_Float16)lo, (_Float16)hi}; return __builtin_bit_cast(unsigned, h); }
__device__ __forceinline__ float f16_lo(unsigned w) { return (float)__builtin_bit_cast(f16x2_t, w)[0]; }
__device__ __forceinline__ float f16_hi(unsigned w) { return (float)__builtin_bit_cast(f16x2_t, w)[1]; }
template <bool F16> __device__ __forceinline__ f32x4 mma16(const bf16x8 b, const bf16x8 a, const f32x4 c) {
    if constexpr (F16) return __builtin_amdgcn_mfma_f32_16x16x32_f16(__builtin_bit_cast(f16x8_t, b), __builtin_bit_cast(f16x8_t, a), c, 0, 0, 0);
    else return __builtin_amdgcn_mfma_f32_16x16x32_bf16(b, a, c, 0, 0, 0);
}
__device__ __forceinline__ float sigmoidf_(float x) { return __builtin_amdgcn_rcpf(1.0f + __builtin_amdgcn_exp2f(x * -1.4426950408889634f)); }
__device__ __forceinline__ float bf_lo(unsigned w) { return __uint_as_float(w << 16); }
__device__ __forceinline__ float bf_hi(unsigned w) { return __uint_as_float(w & 0xffff0000u); }

constexpr float SS_SCALE = 1048576.0f;
__device__ __forceinline__ float row_rstd1(const unsigned long long* ss, size_t row) {
    const unsigned long long v = __hip_atomic_load(ss + row, __ATOMIC_RELAXED, __HIP_MEMORY_SCOPE_AGENT);
    return rsqrtf((float)v * (1.0f / (SS_SCALE * 2048.0f)) + 1e-6f);
}
struct EpiInProj {
    static constexpr bool PERM = true, AFTER_DRAIN = false, USE_UI = true; static constexpr int NSEG = 1;
    bf16_t* O; float* gates; const PG8_LAS float* rsl; int ldc, t_sig0, t_gate, pad_;
    __device__ __forceinline__ void operator()(const f32x4 (&acc)[2][2][4][2], const Unit& u, int ui, int wr, int wc, int fr, int fq) const {
        const int row0 = u.pm * BM + wr * 64 + fr; const int col0 = u.pn * BM + wc * 32 + 8 * fq;
        float rsv[2][4];
#pragma unroll
        for (int ai = 0; ai < 2; ++ai)
#pragma unroll
            for (int m = 0; m < 4; ++m) rsv[ai][m] = rsl[ui * BM + wr * 64 + fr + ai * HALF + m * 16];
        if (u.pn == t_gate) {
            if (wc == 0) {
#pragma unroll
                for (int ai = 0; ai < 2; ++ai)
#pragma unroll
                    for (int m = 0; m < 4; ++m) { float* gp = gates + (size_t)(row0 + ai * HALF + m * 16) * 32 + 8 * fq; const float rs = rsv[ai][m];
                        *(f32x4*)(gp) = acc[ai][0][m][0] * rs; *(f32x4*)(gp + 4) = acc[ai][0][m][1] * rs; }
            }
            return;
        }
        const bool sig = u.pn >= t_sig0;
#pragma unroll
        for (int ai = 0; ai < 2; ++ai)
#pragma unroll
            for (int m = 0; m < 4; ++m) { bf16_t* rowp = O + (size_t)(row0 + ai * HALF + m * 16) * ldc + col0; const float rs = rsv[ai][m];
#pragma unroll
                for (int bj = 0; bj < 2; ++bj) { f32x4 v0 = acc[ai][bj][m][0] * rs, v1 = acc[ai][bj][m][1] * rs;
                    if (sig) {
#pragma unroll
                        for (int j = 0; j < 4; ++j) { v0[j] = sigmoidf_(v0[j]); v1[j] = sigmoidf_(v1[j]); } }
                    u32x4 w; w.x = cvt_pk_bf16(v0[0], v0[1]); w.y = cvt_pk_bf16(v0[2], v0[3]); w.z = cvt_pk_bf16(v1[0], v1[1]); w.w = cvt_pk_bf16(v1[2], v1[3]);
                    __builtin_nontemporal_store(w, (u32x4*)(rowp + bj * HALF)); } }
    }
};

struct EpiBranchCat {
    static constexpr bool PERM = true, AFTER_DRAIN = false, USE_UI = false;
    static constexpr int NSEG = 3, SEG1 = 768 / BK, SEG2 = (768 + 1024) / BK;
    const bf16_t* G; bf16_t* out; int ldg, ldc;
    __device__ __forceinline__ void boundary(f32x4 (&acc)[2][2][4][2], const Unit& u, int seg  , int wr, int wc, int fr, int fq) const {
        int row0 = u.pm * BM + wr * 64 + fr; int col0 = u.pn * BM + wc * 32 + 8 * fq;
        asm volatile("" : "+v"(row0), "+v"(col0));
#pragma unroll
        for (int ai = 0; ai < 2; ++ai) {
            u32x4 gp[4][2], gn[4][2];
#pragma unroll
            for (int m = 0; m < 4; ++m) { const size_t r = (size_t)(row0 + ai * HALF + m * 16);
#pragma unroll
                for (int bj = 0; bj < 2; ++bj) { const int c = col0 + bj * HALF;
                    gp[m][bj] = *(const u32x4*)(G + r * ldg + (size_t)(seg - 1) * ldc + c); gn[m][bj] = *(const u32x4*)(G + r * ldg + (size_t)seg * ldc + c); } }
#pragma unroll
            for (int m = 0; m < 4; ++m)
#pragma unroll
                for (int bj = 0; bj < 2; ++bj) { const u32x4 p_ = gp[m][bj], n_ = gn[m][bj];
                    f32x4 r0, r1;
                    r0[0] = fmaxf(bf_lo(p_.x), 1e-30f) * __builtin_amdgcn_rcpf(fmaxf(bf_lo(n_.x), 1e-30f)); r0[1] = fmaxf(bf_hi(p_.x), 1e-30f) * __builtin_amdgcn_rcpf(fmaxf(bf_hi(n_.x), 1e-30f));
                    r0[2] = fmaxf(bf_lo(p_.y), 1e-30f) * __builtin_amdgcn_rcpf(fmaxf(bf_lo(n_.y), 1e-30f)); r0[3] = fmaxf(bf_hi(p_.y), 1e-30f) * __builtin_amdgcn_rcpf(fmaxf(bf_hi(n_.y), 1e-30f));
                    r1[0] = fmaxf(bf_lo(p_.z), 1e-30f) * __builtin_amdgcn_rcpf(fmaxf(bf_lo(n_.z), 1e-30f)); r1[1] = fmaxf(bf_hi(p_.z), 1e-30f) * __builtin_amdgcn_rcpf(fmaxf(bf_hi(n_.z), 1e-30f));
                    r1[2] = fmaxf(bf_lo(p_.w), 1e-30f) * __builtin_amdgcn_rcpf(fmaxf(bf_lo(n_.w), 1e-30f)); r1[3] = fmaxf(bf_hi(p_.w), 1e-30f) * __builtin_amdgcn_rcpf(fmaxf(bf_hi(n_.w), 1e-30f));
                    acc[ai][bj][m][0] *= r0; acc[ai][bj][m][1] *= r1; }
            asm volatile("" ::: "memory"); }
    }
    __device__ __forceinline__ void operator()(const f32x4 (&acc)[2][2][4][2], const Unit& u, int wr, int wc, int fr, int fq) const {
        const int row0 = u.pm * BM + wr * 64 + fr; const int col0 = u.pn * BM + wc * 32 + 8 * fq;
        u32x4 gall[2][4][2];
#pragma unroll
        for (int ai = 0; ai < 2; ++ai)
#pragma unroll
            for (int m = 0; m < 4; ++m)
#pragma unroll
                for (int bj = 0; bj < 2; ++bj) gall[ai][m][bj] = *(const u32x4*)(G + (size_t)(row0 + ai * HALF + m * 16) * ldg + (size_t)2 * ldc + col0 + bj * HALF);
#pragma unroll
        for (int ai = 0; ai < 2; ++ai)
#pragma unroll
            for (int m = 0; m < 4; ++m) { const size_t r = (size_t)(row0 + ai * HALF + m * 16);
#pragma unroll
                for (int bj = 0; bj < 2; ++bj) { const int c = col0 + bj * HALF;
                    const u32x4 gw = gall[ai][m][bj];
                    f32x4 v0 = acc[ai][bj][m][0], v1 = acc[ai][bj][m][1];
                    v0[0] *= fmaxf(bf_lo(gw.x), 1e-30f); v0[1] *= fmaxf(bf_hi(gw.x), 1e-30f); v0[2] *= fmaxf(bf_lo(gw.y), 1e-30f); v0[3] *= fmaxf(bf_hi(gw.y), 1e-30f);
                    v1[0] *= fmaxf(bf_lo(gw.z), 1e-30f); v1[1] *= fmaxf(bf_hi(gw.z), 1e-30f); v1[2] *= fmaxf(bf_lo(gw.w), 1e-30f); v1[3] *= fmaxf(bf_hi(gw.w), 1e-30f);
                    u32x4 w; w.x = cvt_pk_bf16(v0[0], v0[1]); w.y = cvt_pk_bf16(v0[2], v0[3]); w.z = cvt_pk_bf16(v1[0], v1[1]); w.w = cvt_pk_bf16(v1[2], v1[3]);
                    *(u32x4*)(out + r * ldc + c) = w; } }
    }
};

struct EpiResid {
    static constexpr bool PERM = true, AFTER_DRAIN = false, USE_UI = false; static constexpr int NSEG = 1;
    bf16_t* xh; float* out; unsigned long long* stats; int ldc, fin;
    __device__ __forceinline__ void operator()(const f32x4 (&acc)[2][2][4][2], const Unit& u, int wr, int wc, int fr, int fq) const {
        const int row0 = u.pm * BM + wr * 64 + fr, col0 = u.pn * BM + wc * 32 + 8 * fq;
        bf16_t* const hp0 = xh + ((size_t)u.pm * (ldc / 64) + u.pn * 4 + (wc >> 1)) * 16384 + (wr * 64 + fr) * 64 + (wc & 1) * 32 + 8 * fq;
        u32x4 bq[2][2][2];
#pragma unroll
        for (int mm = 0; mm < 2; ++mm)
#pragma unroll
            for (int bj = 0; bj < 2; ++bj) bq[0][mm][bj] = *(const u32x4*)(hp0 + bj * 2 * 16384 + (mm * 16) * 64);
#pragma unroll
        for (int q = 0; q < 4; ++q) { const int ai = q >> 1, mb = (q & 1) * 2;
            if (q < 3) { const int ai2 = (q + 1) >> 1, mb2 = ((q + 1) & 1) * 2;
#pragma unroll
                for (int mm = 0; mm < 2; ++mm)
#pragma unroll
                    for (int bj = 0; bj < 2; ++bj) bq[(q + 1) & 1][mm][bj] = *(const u32x4*)(hp0 + bj * 2 * 16384 + (ai2 * HALF + (mb2 + mm) * 16) * 64); }
#pragma unroll
            for (int mm = 0; mm < 2; ++mm) { const int m = mb + mm; const size_t row = (size_t)(row0 + ai * HALF + m * 16); float s = 0.f;
#pragma unroll
                for (int bj = 0; bj < 2; ++bj) {
                    bf16_t* hp = hp0 + bj * 2 * 16384 + (ai * HALF + m * 16) * 64;
                    const u32x4 bw = bq[q & 1][mm][bj];
                    f32x4 v0 = acc[ai][bj][m][0], v1 = acc[ai][bj][m][1];
                    v0[0] += f16_lo(bw.x); v0[1] += f16_hi(bw.x); v0[2] += f16_lo(bw.y); v0[3] += f16_hi(bw.y); v1[0] += f16_lo(bw.z); v1[1] += f16_hi(bw.z); v1[2] += f16_lo(bw.w); v1[3] += f16_hi(bw.w);
                    if (fin) { float* op = out + row * ldc + col0 + bj * HALF; *(f32x4*)op = v0; *(f32x4*)(op + 4) = v1; }
                    else { u32x4 w; w.x = cvt_pk_f16(v0[0], v0[1]); w.y = cvt_pk_f16(v0[2], v0[3]); w.z = cvt_pk_f16(v1[0], v1[1]); w.w = cvt_pk_f16(v1[2], v1[3]);
                        *(u32x4*)hp = w;
                        s += (v0[0] * v0[0] + v0[1] * v0[1]) + (v0[2] * v0[2] + v0[3] * v0[3]) + (v1[0] * v1[0] + v1[1] * v1[1]) + (v1[2] * v1[2] + v1[3] * v1[3]); } }
                if (!fin) { s += __shfl_xor(s, 16); s += __shfl_xor(s, 32);
                    if (fq == 0) (void)__hip_atomic_fetch_add(stats + row, (unsigned long long)(s * SS_SCALE + 0.5f), __ATOMIC_RELAXED, __HIP_MEMORY_SCOPE_AGENT); } } }
    }
};

struct EpiRelu2 {
    static constexpr bool PERM = true, AFTER_DRAIN = false, USE_UI = true; static constexpr int NSEG = 1;
    bf16_t* O; const PG8_LAS float* rsl; int ldc, pad_;
    __device__ __forceinline__ void operator()(const f32x4 (&acc)[2][2][4][2], const Unit& u, int ui, int wr, int wc, int fr, int fq) const {
        const int row0 = u.pm * BM + wr * 64 + fr; const int col0 = u.pn * BM + wc * 32 + 8 * fq;
        float rsv[2][4];
#pragma unroll
        for (int ai = 0; ai < 2; ++ai)
#pragma unroll
            for (int m = 0; m < 4; ++m) rsv[ai][m] = rsl[ui * BM + wr * 64 + fr + ai * HALF + m * 16];
#pragma unroll
        for (int ai = 0; ai < 2; ++ai)
#pragma unroll
            for (int m = 0; m < 4; ++m) { bf16_t* rowp = O + ((size_t)u.pm * (ldc / 64) + u.pn * 4 + (wc >> 1)) * 16384 + (wr * 64 + fr + ai * HALF + m * 16) * 64 + (wc & 1) * 32 + 8 * fq;
                const float rs = rsv[ai][m];
#pragma unroll
                for (int bj = 0; bj < 2; ++bj) { f32x4 v0 = acc[ai][bj][m][0] * rs, v1 = acc[ai][bj][m][1] * rs;
#pragma unroll
                    for (int j = 0; j < 4; ++j) { const float a = fmaxf(v0[j], 0.f), b = fmaxf(v1[j], 0.f); v0[j] = a * a; v1[j] = b * b; }
                    u32x4 w; w.x = cvt_pk_bf16(v0[0], v0[1]); w.y = cvt_pk_bf16(v0[2], v0[3]); w.z = cvt_pk_bf16(v1[0], v1[1]); w.w = cvt_pk_bf16(v1[2], v1[3]);
                    __builtin_nontemporal_store(w, (u32x4*)(rowp + bj * 2 * 16384)); } }
    }
};
template <class Epi, class Sched, bool ALIGN_EPI = false, bool SP2 = false, bool PANEL = false, bool F16 = false>
__device__ __forceinline__ void gemm_phase(PG8_LAS unsigned char* lds, const Gemm g, const Sched& S, const Epi& E) {
    const int tid = tid_l(), wid = __builtin_amdgcn_readfirstlane(tid >> 6), lane = tid & 63, wr = wid >> 2, wc = wid & 3, fr = lane & 15, fq = lane >> 4;
    const int K = g.K, nt = K / BK;
    unsigned voffA[2], voffB[2];
#pragma unroll
    for (int i = 0; i < 2; ++i) { int R, C; stage_rc(tid * 16 + i * 8192, R, C); const int Rb = Epi::PERM ? ((R & ~31) + perm32(R & 31)) : R;
        voffA[i] = PANEL ? (unsigned)(R * BK + C) * 2u : (unsigned)(R * K + C) * 2u; voffB[i] = PANEL ? (unsigned)(Rb * BK + C) * 2u : (unsigned)(Rb * K + C) * 2u; }
    const size_t kstep = PANEL ? (size_t)(BM * BK * 2) : (size_t)(BK * 2);
    const size_t hstep = PANEL ? (size_t)(HALF * BK * 2) : (size_t)HALF * K * 2;
    const size_t tstep = PANEL ? (size_t)nt * (BM * BK * 2) : 2 * hstep;
    const unsigned ldsw = (unsigned)wid * 1024u;
    const int aoff = lds_byte(wr * 64 + fr, fq * 8), boff = lds_byte(wc * 32 + fr, fq * 8);
#define PG8_SA(b, h) (((b) * 2 + (h)) * HTB)
#define PG8_SB(b, h) ((4 + (b) * 2 + (h)) * HTB)
#define PG8_STAGE(bufoff, gbase, voff) do { _Pragma("unroll") for (int _i = 0; _i < 2; ++_i) \
        __builtin_amdgcn_global_load_lds((const unsigned*)((const char*)(gbase) + (voff)[_i]), (PG8_LAS unsigned*)(lds + (bufoff) + ldsw + _i * 8192), 16, 0, 0); } while (0)
#define PG8_LDA(dst, b, h) do { _Pragma("unroll") for (int m = 0; m < 4; ++m) _Pragma("unroll") for (int k = 0; k < 2; ++k) dst[m][k] = *(const PG8_LAS bf16x8*)(lds + PG8_SA(b, h) + aoff + m * 2048 + k * 1024); } while (0)
#define PG8_LDB(dst, b, h) do { _Pragma("unroll") for (int n = 0; n < 2; ++n) _Pragma("unroll") for (int k = 0; k < 2; ++k) dst[n][k] = *(const PG8_LAS bf16x8*)(lds + PG8_SB(b, h) + boff + n * 2048 + k * 1024); } while (0)
#define PG8_MMA(ai, bj, At, Bt) do { __builtin_amdgcn_s_setprio(1); _Pragma("unroll") for (int m = 0; m < 4; ++m) _Pragma("unroll") for (int n = 0; n < 2; ++n) _Pragma("unroll") for (int k = 0; k < 2; ++k) \
        acc[ai][bj][m][n] = mma16<F16>(Bt[n][k], At[m][k], acc[ai][bj][m][n]); __builtin_amdgcn_s_setprio(0); } while (0)
#define PG8_WAIT_V(n) asm volatile("s_waitcnt vmcnt(" #n ")" ::: "memory")
#define PG8_WAIT_L(n) asm volatile("s_waitcnt lgkmcnt(" #n ")" ::: "memory")
#define PG8_BAR __builtin_amdgcn_s_barrier()
#define PG8_SCHED __builtin_amdgcn_sched_barrier(0)
    Unit cur, nxt; int ui = 0;
    if (!S.next(0, cur)) return;
    f32x4 acc[2][2][4][2];
#pragma unroll
    for (int a = 0; a < 2; ++a)
#pragma unroll
        for (int b = 0; b < 2; ++b)
#pragma unroll
            for (int m = 0; m < 4; ++m)
#pragma unroll
                for (int n = 0; n < 2; ++n) acc[a][b][m][n] = (f32x4){0.f, 0.f, 0.f, 0.f};
    bf16x8 At[4][2], B0[2][2], B1[2][2];
    const char* cA = (const char*)g.A + (size_t)cur.pm * tstep; const char* cB = (const char*)g.Bt + (size_t)cur.pn * tstep;
    S.a_ready(cur);
    if constexpr (SP2) {
        PG8_STAGE(PG8_SB(0, 0), cB, voffB); PG8_STAGE(PG8_SB(0, 1), cB + hstep, voffB); PG8_STAGE(PG8_SA(0, 0), cA, voffA); PG8_STAGE(PG8_SA(0, 1), cA + hstep, voffA);
        if (wr == 1) PG8_BAR;
        PG8_WAIT_V(2); PG8_BAR;
        PG8_STAGE(PG8_SB(1, 0), cB + kstep, voffB); PG8_STAGE(PG8_SA(1, 0), cA + kstep, voffA); PG8_STAGE(PG8_SB(1, 1), cB + hstep + kstep, voffB);
        PG8_WAIT_V(6); PG8_BAR;
    } else {
        PG8_STAGE(PG8_SB(0, 0), cB, voffB); PG8_STAGE(PG8_SA(0, 0), cA, voffA); PG8_STAGE(PG8_SB(0, 1), cB + hstep, voffB); PG8_STAGE(PG8_SA(0, 1), cA + hstep, voffA);
        if (wr == 1) PG8_BAR;
        PG8_WAIT_V(4); PG8_BAR;
        PG8_STAGE(PG8_SB(1, 0), cB + kstep, voffB); PG8_STAGE(PG8_SA(1, 0), cA + kstep, voffA); PG8_STAGE(PG8_SB(1, 1), cB + hstep + kstep, voffB);
        PG8_WAIT_V(6); PG8_BAR;
    }
    for (;;) {
        const bool has_next = S.next(ui + 1, nxt);
        const char* nA = has_next ? (const char*)g.A + (size_t)nxt.pm * tstep : cA; const char* nB = has_next ? (const char*)g.Bt + (size_t)nxt.pn * tstep : cB;
        for (int t = 0; t < nt; t += 2) {
            const bool last = (t == nt - 2);
            const char* a1 = cA + (size_t)(t + 1) * kstep;
            const char* a2 = last ? nA : cA + (size_t)(t + 2) * kstep; const char* b2 = last ? nB : cB + (size_t)(t + 2) * kstep;
            const char* a3 = a2 + kstep; const char* b3 = b2 + kstep;
            if (last && has_next) S.a_ready(nxt);
            if constexpr (Epi::NSEG > 1) { if (t == Epi::SEG1 || t == Epi::SEG2) E.boundary(acc, cur, t == Epi::SEG1 ? 1 : 2, wr, wc, fr, fq); }
            if constexpr (SP2) {
            PG8_LDB(B0, 0, 0); PG8_LDB(B1, 0, 1); PG8_SCHED; PG8_LDA(At, 0, 0); PG8_STAGE(PG8_SA(1, 1), a1 + hstep, voffA);
            PG8_WAIT_V(8); PG8_WAIT_L(0); PG8_BAR; PG8_MMA(0, 0, At, B0); PG8_MMA(0, 1, At, B1); PG8_BAR; PG8_SCHED;
            PG8_LDA(At, 0, 1); PG8_STAGE(PG8_SB(0, 0), b2, voffB); PG8_STAGE(PG8_SB(0, 1), b2 + hstep, voffB); PG8_STAGE(PG8_SA(0, 0), a2, voffA);
            PG8_WAIT_V(8); PG8_WAIT_L(0); PG8_BAR; PG8_MMA(1, 0, At, B0); PG8_MMA(1, 1, At, B1); PG8_BAR; PG8_SCHED;
            PG8_LDB(B0, 1, 0); PG8_LDB(B1, 1, 1); PG8_SCHED; PG8_LDA(At, 1, 0); PG8_STAGE(PG8_SA(0, 1), a2 + hstep, voffA);
            PG8_WAIT_V(8); PG8_WAIT_L(0); PG8_BAR; PG8_MMA(0, 0, At, B0); PG8_MMA(0, 1, At, B1); PG8_BAR; PG8_SCHED;
            PG8_LDA(At, 1, 1); PG8_STAGE(PG8_SB(1, 0), b3, voffB); PG8_STAGE(PG8_SB(1, 1), b3 + hstep, voffB); PG8_STAGE(PG8_SA(1, 0), a3, voffA);
            PG8_WAIT_V(8); PG8_WAIT_L(0); PG8_BAR; PG8_MMA(1, 0, At, B0); PG8_MMA(1, 1, At, B1); PG8_BAR; PG8_SCHED;
            } else {
            PG8_LDB(B0, 0, 0); PG8_SCHED; PG8_LDA(At, 0, 0); PG8_STAGE(PG8_SA(1, 1), a1 + hstep, voffA);
            PG8_WAIT_L(8); PG8_BAR; PG8_WAIT_L(0); PG8_MMA(0, 0, At, B0); PG8_BAR; PG8_SCHED;
            PG8_LDB(B1, 0, 1); PG8_STAGE(PG8_SB(0, 0), b2, voffB);
            PG8_BAR; PG8_WAIT_L(0); PG8_MMA(0, 1, At, B1); PG8_BAR;
            PG8_LDA(At, 0, 1); PG8_STAGE(PG8_SA(0, 0), a2, voffA);
            PG8_BAR; PG8_WAIT_L(0); PG8_MMA(1, 0, At, B0); PG8_BAR; PG8_SCHED;
            PG8_STAGE(PG8_SB(0, 1), b2 + hstep, voffB);
            PG8_WAIT_V(6); PG8_BAR; PG8_MMA(1, 1, At, B1); PG8_BAR;
            PG8_LDB(B0, 1, 0); PG8_SCHED; PG8_LDA(At, 1, 0); PG8_STAGE(PG8_SA(0, 1), a2 + hstep, voffA);
            PG8_WAIT_L(8); PG8_BAR; PG8_WAIT_L(0); PG8_MMA(0, 0, At, B0); PG8_BAR; PG8_SCHED;
            PG8_LDB(B1, 1, 1); PG8_STAGE(PG8_SB(1, 0), b3, voffB);
            PG8_BAR; PG8_WAIT_L(0); PG8_MMA(0, 1, At, B1); PG8_BAR;
            PG8_LDA(At, 1, 1); PG8_STAGE(PG8_SA(1, 0), a3, voffA);
            PG8_BAR; PG8_WAIT_L(0); PG8_MMA(1, 0, At, B0); PG8_BAR; PG8_SCHED;
            PG8_STAGE(PG8_SB(1, 1), b3 + hstep, voffB);
            PG8_WAIT_V(6); PG8_BAR; PG8_MMA(1, 1, At, B1); PG8_BAR;
            }
        }
        if constexpr (ALIGN_EPI) { if (wr == 0) PG8_BAR; }
        if constexpr (!Epi::AFTER_DRAIN) { if constexpr (Epi::USE_UI) E(acc, cur, ui, wr, wc, fr, fq); else E(acc, cur, wr, wc, fr, fq); S.done(cur); }
        if (!has_next) break;
#pragma unroll
        for (int a = 0; a < 2; ++a)
#pragma unroll
            for (int b = 0; b < 2; ++b)
#pragma unroll
                for (int m = 0; m < 4; ++m)
#pragma unroll
                    for (int n = 0; n < 2; ++n) acc[a][b][m][n] = (f32x4){0.f, 0.f, 0.f, 0.f};
        cur = nxt; cA = nA; cB = nB; ++ui;
        if constexpr (ALIGN_EPI) { if (wr == 1) PG8_BAR; }
    }
    PG8_WAIT_V(0);
    if constexpr (!ALIGN_EPI) { if (wr == 0) PG8_BAR; }
    PG8_BAR;
    if constexpr (Epi::AFTER_DRAIN) { E.fused(acc, cur, wr, wc, fr, fq, lds, wid, lane); S.done(cur); }
#undef PG8_SA
#undef PG8_SB
#undef PG8_STAGE
#undef PG8_LDA
#undef PG8_LDB
#undef PG8_MMA
#undef PG8_WAIT_V
#undef PG8_WAIT_L
#undef PG8_BAR
#undef PG8_SCHED
}
}

#define XB_TMO      128
#define XB_XCNT(j)  (256  + 64 * (j))
#define XB_XSUB(j)  (1280 + 64 * (j))
#define XB_XGEN(j)  (2304 + 64 * (j))
#define XB_TOP      3328
#define XB_TOPGEN   3392
#define XCD_BAR_WORDS 3456
#define XB_SPIN_CAP (1u << 18)
#define LAS __attribute__((address_space(3)))

__device__ __forceinline__ unsigned xb_ld(unsigned* p)              { return __hip_atomic_load(p, __ATOMIC_RELAXED, __HIP_MEMORY_SCOPE_AGENT); }
__device__ __forceinline__ unsigned xb_add(unsigned* p, unsigned v) { return __hip_atomic_fetch_add(p, v, __ATOMIC_RELAXED, __HIP_MEMORY_SCOPE_AGENT); }
__device__ __forceinline__ unsigned xb_xcc_id() { return (unsigned)__builtin_amdgcn_s_getreg((3 << 11) | 20) & 0xFu; }
#define XB_SPIN(cond, bar) do { unsigned _sp = 0; while (cond) { __builtin_amdgcn_s_sleep(1); \
    if ((++_sp & 255u) == 0u) { if (xb_ld(&(bar)[XB_TMO])) break; if (_sp > XB_SPIN_CAP) { atomicAdd(&(bar)[XB_TMO], 1u); break; } } } } while (0)

struct XcdBarrier {
    unsigned* bar; unsigned x;
    volatile LAS unsigned* st;
};

__device__ __forceinline__ XcdBarrier xcd_barrier_post(unsigned* bar, volatile LAS unsigned* st) {
    XcdBarrier b; b.bar = bar; b.x = xb_xcc_id(); b.st = st;
    if (threadIdx.x == 0) (void)xb_add(&bar[XB_XCNT(b.x)], 1u);
    return b;
}
__device__ __forceinline__ void xcd_barrier_complete(unsigned* bar, unsigned x, unsigned& nloc, unsigned& nx) {
    const unsigned G = gridDim.x * gridDim.y * gridDim.z;
    unsigned sum, cnt, mine, sp = 0u;
    for (;;) {
        sum = 0u; cnt = 0u; mine = 0u;
#pragma unroll
        for (unsigned j = 0; j < 16; ++j) { const unsigned c = xb_ld(&bar[XB_XCNT(j)]); sum += c; cnt += (c > 0u) ? 1u : 0u; mine = (j == x) ? c : mine; }
        if (sum == G) break;
        __builtin_amdgcn_s_sleep(1);
        if ((++sp & 255u) == 0u) { if (xb_ld(&bar[XB_TMO])) break; if (sp > XB_SPIN_CAP) { atomicAdd(&bar[XB_TMO], 1u); break; } }
    }
    nloc = mine > 0u ? mine : 1u; nx = cnt > 0u ? cnt : 1u;
}

__device__ __forceinline__ void xcd_barrier(const XcdBarrier& b) {
    asm volatile("s_waitcnt vmcnt(0)" ::: "memory");
    __syncthreads();
    if (threadIdx.x == 0) {
        unsigned* bar = b.bar;
        __builtin_amdgcn_s_waitcnt(0);
        unsigned nloc = b.st[0], nx = b.st[1];
        if (nloc == 0u) { xcd_barrier_complete(bar, b.x, nloc, nx); b.st[0] = nloc; b.st[1] = nx; }
        const unsigned old = xb_add(&bar[XB_XSUB(b.x)], 1u);
        const unsigned gen = old / nloc;
        if (old + 1u == (gen + 1u) * nloc) {
            __builtin_amdgcn_fence(__ATOMIC_RELEASE, "agent");
            asm volatile("s_waitcnt vmcnt(0)" ::: "memory");
            const unsigned og = xb_add(&bar[XB_TOP], 1u);
            const unsigned tg = og / nx;
            if (og + 1u == (tg + 1u) * nx) xb_add(&bar[XB_TOPGEN], 1u);
            else XB_SPIN(xb_ld(&bar[XB_TOPGEN]) == tg, bar);
            __builtin_amdgcn_fence(__ATOMIC_ACQUIRE, "agent");
            xb_add(&bar[XB_XGEN(b.x)], 1u);
            asm volatile("s_waitcnt vmcnt(0)" ::: "memory");
        } else {
            XB_SPIN(xb_ld(&bar[XB_XGEN(b.x)]) == gen, bar);
            __builtin_amdgcn_fence(__ATOMIC_ACQUIRE, "agent");
            asm volatile("s_waitcnt vmcnt(0)" ::: "memory");
        }
    }
    __syncthreads();
}

typedef unsigned short bf16_t;
typedef unsigned u32x4_t __attribute__((ext_vector_type(4)));
typedef unsigned u32x2_t __attribute__((ext_vector_type(2)));
typedef float f32x4_t __attribute__((ext_vector_type(4)));
constexpr int NB = 4, SEQ = 4096, DM = 2048, MTOK = NB * SEQ, DEPTH = 4, DFF = 8192;
constexpr int LDP = 13312, IN_COLS = 13088;
constexpr int COL_AQ = 0, COL_AK = 768, COL_AV = 1536, COL_BQ = 2304, COL_BK = 3328, COL_BV = 3584, COL_CQK = 3840, COL_CV = 4864, COL_CO = 5888, COL_G = 6912, COL_GATE = 13056;
constexpr int OCOL_GATE = 6912, OCOL_G = 6944;
constexpr float EPS = 1e-6f;
constexpr size_t al256(size_t x) { return (x + 255) / 256 * 256; }
constexpr size_t WS_CTRL = 0;
constexpr size_t WS_WT_IN = 16384;
constexpr size_t SZ_WT_IN = (size_t)LDP * DM * 2;
constexpr size_t WS_WT_A = WS_WT_IN + DEPTH * SZ_WT_IN;
constexpr size_t SZ_WT_A = (size_t)DM * 768 * 2;
constexpr int YK = 2816;
constexpr size_t SZ_WT_CAT = (size_t)DM * YK * 2;
constexpr size_t WS_WT_B = WS_WT_A + DEPTH * SZ_WT_A;
constexpr size_t SZ_WT_B = (size_t)DM * 1024 * 2;
constexpr size_t WS_WT_C = WS_WT_B + DEPTH * SZ_WT_B;
constexpr size_t WS_WT_OUT = WS_WT_C + DEPTH * SZ_WT_B;
constexpr size_t SZ_WT_OUT = (size_t)DM * DM * 2;
constexpr size_t WS_WT_UP = WS_WT_OUT + DEPTH * SZ_WT_OUT;
constexpr size_t SZ_WT_UP = (size_t)DFF * DM * 2;
constexpr size_t WS_WT_DOWN = WS_WT_UP + DEPTH * SZ_WT_UP;
constexpr size_t WS_ROPE1 = WS_WT_DOWN + DEPTH * SZ_WT_UP;
constexpr size_t WS_ROPEAX = WS_ROPE1 + 2 * (size_t)SEQ * 64 * 4;
constexpr size_t WS_XN = al256(WS_ROPEAX + 2 * 64 * 32 * 4);
constexpr size_t WS_P = WS_XN + (size_t)MTOK * DM * 2;
constexpr size_t WS_GATES = WS_P + (size_t)MTOK * LDP * 2;
constexpr size_t WS_CQ = WS_GATES + (size_t)MTOK * 32 * 4;
constexpr size_t WS_CK = WS_CQ + (size_t)MTOK * 512 * 2;
constexpr size_t WS_GA = WS_CK + (size_t)MTOK * 512 * 2;
constexpr size_t WS_GM = WS_GA + 64 * (size_t)SEQ * 4;
constexpr size_t WS_GF = WS_GM + 64 * (size_t)SEQ * 4;
constexpr size_t WS_YA = WS_GF + 64 * (size_t)SEQ * 4;
constexpr size_t WS_YB = WS_YA + (size_t)MTOK * 768 * 2;
constexpr size_t WS_YC = WS_YB + (size_t)MTOK * 1024 * 2;
constexpr size_t WS_SBUF = WS_YC + (size_t)MTOK * 1024 * 2;
constexpr size_t WS_NBUF = WS_SBUF + (size_t)4096 * 8192 * 4;
constexpr size_t WS_MERGED = WS_NBUF + (size_t)4096 * 64 * 4;
constexpr size_t WS_OA = WS_MERGED + (size_t)MTOK * DM * 2;
constexpr size_t WS_LSE = WS_OA + 3 * (size_t)MTOK * 768 * 2;
constexpr size_t WS_KT = al256(WS_LSE + 3 * (size_t)MTOK * 6 * 4);
constexpr size_t WS_VT = WS_KT + (size_t)MTOK * 512 * 2;
constexpr size_t WS_STATS = WS_VT + (size_t)MTOK * 1024 * 2;
constexpr size_t WS_END = WS_STATS + (size_t)MTOK * 32 * 4;

struct Params {
    const float* x; const float* norm1_g; const float* w_in; const float* a_q_gain; const float* a_k_gain; const float* b_q_gain; const float* b_k_gain;
    const float* c_conv_w; const float* c_conv_b; const float* c_gate_b; const float* c_out_g; const float* w_a; const float* w_b; const float* w_c;
    const float* w_out; const float* norm2_g; const float* w_up; const float* w_down;
    float* out; unsigned char* ws;
};

__device__ __forceinline__ float bf2f(bf16_t h) { return __uint_as_float((unsigned)h << 16); }
__device__ __forceinline__ bf16_t f2bf(float f) { return (bf16_t)(pg8::cvt_pk_bf16(f, 0.f) & 0xffffu); }
__device__ __forceinline__ float wave_sum(float v) {
#pragma unroll
    for (int o = 32; o >= 1; o >>= 1) v += __shfl_xor(v, o);
    return v;
}
__device__ __forceinline__ float wave_max(float v) {
#pragma unroll
    for (int o = 32; o >= 1; o >>= 1) v = fmaxf(v, __shfl_xor(v, o));
    return v;
}

constexpr int CVT_TPL = 17280, CVT_TILES = DEPTH * CVT_TPL;
__device__ __forceinline__ void cvt_wave_tile(const Params& p, int it, int lane) {
    constexpr int T0 = 3456, T1 = T0 + 3072, T2 = T1 + 128, T3 = T2 + 384, T4 = T3 + 512, T5 = T4 + 512, T6 = T5 + 1024, T7 = T6 + 4096, T8 = T7 + 4096;
    static_assert(T8 == CVT_TPL, "tile count");
        const int l = it / T8; int t = it % T8;
        const float* src; bf16_t* dst; int K, ld, col0, nsrc, ntn, ldd = 0; const float* gain = nullptr; bool panel = false, f16 = false;
        unsigned char* ws = p.ws;
        if (t < T0) { src = p.w_in + (size_t)l * DM * IN_COLS; dst = (bf16_t*)(ws + WS_WT_IN + l * SZ_WT_IN); K = DM; ld = IN_COLS; col0 = 0; nsrc = 6912; ntn = 108; gain = p.norm1_g + l * DM; panel = true; f16 = true; }
        else if (t < T1) { t -= T0; src = p.w_in + (size_t)l * DM * IN_COLS; dst = (bf16_t*)(ws + WS_WT_IN + l * SZ_WT_IN) + (size_t)COL_G * DM; K = DM; ld = IN_COLS; col0 = OCOL_G; nsrc = 6144; ntn = 96; gain = p.norm1_g + l * DM; panel = true; f16 = true; }
        else if (t < T2) { t -= T1; src = p.w_in + (size_t)l * DM * IN_COLS; dst = (bf16_t*)(ws + WS_WT_IN + l * SZ_WT_IN) + (size_t)COL_GATE * DM; K = DM; ld = IN_COLS; col0 = OCOL_GATE; nsrc = 32; ntn = 4; gain = p.norm1_g + l * DM; panel = true; f16 = true; }
        else if (t < T3) { t -= T2; src = p.w_a + (size_t)l * 768 * DM; dst = (bf16_t*)(ws + WS_WT_A + l * SZ_WT_CAT); K = 768; ld = DM; col0 = 0; nsrc = DM; ntn = 32; ldd = YK; }
        else if (t < T4) { t -= T3; src = p.w_b + (size_t)l * 1024 * DM; dst = (bf16_t*)(ws + WS_WT_A + l * SZ_WT_CAT) + 768; K = 1024; ld = DM; col0 = 0; nsrc = DM; ntn = 32; ldd = YK; }
        else if (t < T5) { t -= T4; src = p.w_c + (size_t)l * 1024 * DM; dst = (bf16_t*)(ws + WS_WT_A + l * SZ_WT_CAT) + 1792; K = 1024; ld = DM; col0 = 0; nsrc = DM; ntn = 32; ldd = YK; }
        else if (t < T6) { t -= T5; src = p.w_out + (size_t)l * DM * DM; dst = (bf16_t*)(ws + WS_WT_OUT + l * SZ_WT_OUT); K = DM; ld = DM; col0 = 0; nsrc = DM; ntn = 32; }
        else if (t < T7) { t -= T6; src = p.w_up + (size_t)l * DM * DFF; dst = (bf16_t*)(ws + WS_WT_UP + l * SZ_WT_UP); K = DM; ld = DFF; col0 = 0; nsrc = DFF; ntn = 128; gain = p.norm2_g + l * DM; panel = true; f16 = true; }
        else { t -= T7; src = p.w_down + (size_t)l * DFF * DM; dst = (bf16_t*)(ws + WS_WT_DOWN + l * SZ_WT_UP); K = DFF; ld = DM; col0 = 0; nsrc = DM; ntn = 32; panel = true; }
        const int tk = t / ntn, tn = t % ntn, kg = lane & 7, ng = lane >> 3;
        const int n = tn * 64 + 8 * ng, k0 = tk * 64 + 8 * kg; const bool valid = n < nsrc;
        float v[8][8];
#pragma unroll
        for (int i = 0; i < 8; ++i) { f32x4_t a = {0.f, 0.f, 0.f, 0.f}, b = {0.f, 0.f, 0.f, 0.f};
            if (valid) { const float* sp = src + (size_t)(k0 + i) * ld + col0 + n; a = *(const f32x4_t*)sp; b = *(const f32x4_t*)(sp + 4); }
            const float gk = gain ? gain[k0 + i] : 1.0f;
            v[i][0] = a[0] * gk; v[i][1] = a[1] * gk; v[i][2] = a[2] * gk; v[i][3] = a[3] * gk; v[i][4] = b[0] * gk; v[i][5] = b[1] * gk; v[i][6] = b[2] * gk; v[i][7] = b[3] * gk; }
        const int rs = ldd ? ldd : K;
#pragma unroll
        for (int j = 0; j < 8; ++j) { const int ng_ = n + j;
            u32x4_t w;
            if (f16) { w.x = pg8::cvt_pk_f16(v[0][j], v[1][j]); w.y = pg8::cvt_pk_f16(v[2][j], v[3][j]); w.z = pg8::cvt_pk_f16(v[4][j], v[5][j]); w.w = pg8::cvt_pk_f16(v[6][j], v[7][j]); }
            else { w.x = pg8::cvt_pk_bf16(v[0][j], v[1][j]); w.y = pg8::cvt_pk_bf16(v[2][j], v[3][j]); w.z = pg8::cvt_pk_bf16(v[4][j], v[5][j]); w.w = pg8::cvt_pk_bf16(v[6][j], v[7][j]); }
            if (panel) *(u32x4_t*)(dst + ((size_t)(ng_ >> 8) * (K / 64) + tk) * 16384 + (ng_ & 255) * 64 + 8 * kg) = w;
            else *(u32x4_t*)(dst + (size_t)ng_ * rs + k0) = w; }
}
__device__ __forceinline__ void ph_tables(const Params& p, int bid, int nblk) {
    float* c1 = (float*)(p.ws + WS_ROPE1); float* s1 = c1 + SEQ * 64;
    const int tid0 = tid_l();
    for (int i = bid * 512 + tid0; i < SEQ * 64; i += nblk * 512) {
        const int pos = i >> 6, f = i & 63;
        const float inv = powf(10000.0f, -(float)(2 * f) / 128.0f); const float ang = (float)pos * inv;
        float sn, cs; sincosf(ang, &sn, &cs); c1[i] = cs; s1[i] = sn;
    }
    float* ca = (float*)(p.ws + WS_ROPEAX); float* sa = ca + 64 * 32;
    for (int i = bid * 512 + tid0; i < 64 * 32; i += nblk * 512) {
        const int pos = i >> 5, f = i & 31;
        const float inv = powf(10000.0f, -(float)(2 * f) / 64.0f); const float ang = (float)pos * inv;
        float sn, cs; sincosf(ang, &sn, &cs); ca[i] = cs; sa[i] = sn;
    }
}

__device__ __forceinline__ void ph_xprep(const float* __restrict__ X, bf16_t* __restrict__ O, unsigned long long* __restrict__ stats, int bid, int nblk) {
    const int tid = tid_l(); const int wid = tid >> 6, lane = tid & 63;
    for (int row = bid * 8 + wid; row < MTOK; row += nblk * 8) {
        const f32x4_t* xr = (const f32x4_t*)(X + (size_t)row * DM);
        f32x4_t v[8]; float ss = 0.f;
#pragma unroll
        for (int i = 0; i < 8; ++i) { v[i] = xr[lane + 64 * i]; ss += v[i][0] * v[i][0] + v[i][1] * v[i][1] + v[i][2] * v[i][2] + v[i][3] * v[i][3]; }
        ss = wave_sum(ss);
#pragma unroll
        for (int i = 0; i < 8; ++i) { u32x2_t w; w.x = pg8::cvt_pk_f16(v[i][0], v[i][1]); w.y = pg8::cvt_pk_f16(v[i][2], v[i][3]); const int c = (lane + 64 * i) * 4; *(u32x2_t*)(O + ((size_t)(row >> 8) * (DM / 64) + (c >> 6)) * 16384 + (row & 255) * 64 + (c & 63)) = w; }
        if (lane == 0) stats[row] = (unsigned long long)(ss * pg8::SS_SCALE + 0.5f);
    }
}

struct QkItem { u32x4_t w1, w2; f32x4_t ga, gb, gc, gd, ca0, ca1, sa0, sa1; bf16_t* p1; bf16_t* p2; };
__device__ __forceinline__ void qk_load(QkItem& q, const Params& p, int layer, bf16_t* P, const float* c1, const float* s1, const float* ca, const float* sa, int item, int j) {
    const int row = item / 22, hi = item % 22, t = row & (SEQ - 1);
    int cb; const float* gain; bool axial;
    if (hi < 6) { cb = COL_AQ + hi * 128; gain = p.a_q_gain + layer * 128; axial = false; }
    else if (hi < 12) { cb = COL_AK + (hi - 6) * 128; gain = p.a_k_gain + layer * 128; axial = false; }
    else if (hi < 20) { cb = COL_BQ + (hi - 12) * 128; gain = p.b_q_gain + layer * 128; axial = true; }
    else { cb = COL_BK + (hi - 20) * 128; gain = p.b_k_gain + layer * 128; axial = true; }
    const int e1 = axial ? 8 * j + (j >= 4 ? 32 : 0) : 8 * j, e2 = e1 + (axial ? 32 : 64);
    const float* ct; const float* st;
    if (!axial) { ct = c1 + t * 64 + 8 * j; st = s1 + t * 64 + 8 * j; }
    else { const int pi = j < 4 ? (t >> 6) : (t & 63); ct = ca + pi * 32 + 8 * (j & 3); st = sa + pi * 32 + 8 * (j & 3); }
    bf16_t* pr = P + (size_t)row * LDP + cb; q.p1 = pr + e1; q.p2 = pr + e2;
    q.w1 = *(const u32x4_t*)q.p1; q.w2 = *(const u32x4_t*)q.p2;
    q.ga = *(const f32x4_t*)(gain + e1); q.gb = *(const f32x4_t*)(gain + e1 + 4); q.gc = *(const f32x4_t*)(gain + e2); q.gd = *(const f32x4_t*)(gain + e2 + 4);
    q.ca0 = *(const f32x4_t*)(ct); q.ca1 = *(const f32x4_t*)(ct + 4); q.sa0 = *(const f32x4_t*)(st); q.sa1 = *(const f32x4_t*)(st + 4);
}
__device__ __forceinline__ void qk_finish(const QkItem& q) {
    const u32x4_t w1 = q.w1, w2 = q.w2;
    const float x1[8] = {pg8::bf_lo(w1.x), pg8::bf_hi(w1.x), pg8::bf_lo(w1.y), pg8::bf_hi(w1.y), pg8::bf_lo(w1.z), pg8::bf_hi(w1.z), pg8::bf_lo(w1.w), pg8::bf_hi(w1.w)};
    const float x2[8] = {pg8::bf_lo(w2.x), pg8::bf_hi(w2.x), pg8::bf_lo(w2.y), pg8::bf_hi(w2.y), pg8::bf_lo(w2.z), pg8::bf_hi(w2.z), pg8::bf_lo(w2.w), pg8::bf_hi(w2.w)};
    const float g1[8] = {q.ga[0], q.ga[1], q.ga[2], q.ga[3], q.gb[0], q.gb[1], q.gb[2], q.gb[3]}, g2[8] = {q.gc[0], q.gc[1], q.gc[2], q.gc[3], q.gd[0], q.gd[1], q.gd[2], q.gd[3]};
    const float cs[8] = {q.ca0[0], q.ca0[1], q.ca0[2], q.ca0[3], q.ca1[0], q.ca1[1], q.ca1[2], q.ca1[3]}, sn[8] = {q.sa0[0], q.sa0[1], q.sa0[2], q.sa0[3], q.sa1[0], q.sa1[1], q.sa1[2], q.sa1[3]};
    float ss = 0.f;
#pragma unroll
    for (int i = 0; i < 8; ++i) ss += x1[i] * x1[i] + x2[i] * x2[i];
    ss += __shfl_xor(ss, 1); ss += __shfl_xor(ss, 2); ss += __shfl_xor(ss, 4);
    const float r = rsqrtf(ss * (1.0f / 128.0f) + EPS);
    float o1[8], o2[8];
#pragma unroll
    for (int i = 0; i < 8; ++i) { const float n1 = x1[i] * r * g1[i], n2 = x2[i] * r * g2[i]; o1[i] = n1 * cs[i] - n2 * sn[i]; o2[i] = n2 * cs[i] + n1 * sn[i]; }
    u32x4_t q1, q2;
    q1.x = pg8::cvt_pk_bf16(o1[0], o1[1]); q1.y = pg8::cvt_pk_bf16(o1[2], o1[3]); q1.z = pg8::cvt_pk_bf16(o1[4], o1[5]); q1.w = pg8::cvt_pk_bf16(o1[6], o1[7]);
    q2.x = pg8::cvt_pk_bf16(o2[0], o2[1]); q2.y = pg8::cvt_pk_bf16(o2[2], o2[3]); q2.z = pg8::cvt_pk_bf16(o2[4], o2[5]); q2.w = pg8::cvt_pk_bf16(o2[6], o2[7]);
    *(u32x4_t*)q.p1 = q1; *(u32x4_t*)q.p2 = q2;
}
__device__ __forceinline__ void conv_wave_item(const Params& p, int layer, int witem, int lane) {
    const bf16_t* P = (const bf16_t*)(p.ws + WS_P);
    bf16_t* cq = (bf16_t*)(p.ws + WS_CQ); bf16_t* ck = (bf16_t*)(p.ws + WS_CK); bf16_t* Kt = (bf16_t*)(p.ws + WS_KT);
    const float* cw = p.c_conv_w + (size_t)layer * 5 * 1024; const float* cbias = p.c_conv_b + (size_t)layer * 1024;
        const int half = witem >> 11, cidx = (witem & 2047) >> 3, pg = witem & 7, b = cidx >> 6, pc = cidx & 63;
        const int c8 = lane * 8, ch = half * 512 + c8, t0 = pc * 64 + pg * 8; const size_t row0 = (size_t)b * SEQ + t0;
        float x[12][8];
#pragma unroll
        for (int r = 0; r < 12; ++r) { const int tt = t0 + r - 2; u32x4_t w = {0u, 0u, 0u, 0u};
            if (tt >= 0 && tt < SEQ) w = *(const u32x4_t*)(P + (row0 + r - 2) * LDP + COL_CQK + ch);
            x[r][0] = pg8::bf_lo(w.x); x[r][1] = pg8::bf_hi(w.x); x[r][2] = pg8::bf_lo(w.y); x[r][3] = pg8::bf_hi(w.y); x[r][4] = pg8::bf_lo(w.z); x[r][5] = pg8::bf_hi(w.z); x[r][6] = pg8::bf_lo(w.w); x[r][7] = pg8::bf_hi(w.w); }
        float wt[5][8], bs[8];
#pragma unroll
        for (int j = 0; j < 5; ++j) { const f32x4_t wa = *(const f32x4_t*)(cw + j * 1024 + ch), wb = *(const f32x4_t*)(cw + j * 1024 + ch + 4);
            wt[j][0] = wa[0]; wt[j][1] = wa[1]; wt[j][2] = wa[2]; wt[j][3] = wa[3]; wt[j][4] = wb[0]; wt[j][5] = wb[1]; wt[j][6] = wb[2]; wt[j][7] = wb[3]; }
        { const f32x4_t b0 = *(const f32x4_t*)(cbias + ch), b1 = *(const f32x4_t*)(cbias + ch + 4); bs[0] = b0[0]; bs[1] = b0[1]; bs[2] = b0[2]; bs[3] = b0[3]; bs[4] = b1[0]; bs[5] = b1[1]; bs[6] = b1[2]; bs[7] = b1[3]; }
        const float sc = half ? 0.125f : 1.0f;
        unsigned yk[8][4];
#pragma unroll
        for (int q = 0; q < 8; ++q) { float y[8];
#pragma unroll
            for (int i = 0; i < 8; ++i) { float a = bs[i];
#pragma unroll
                for (int j = 0; j < 5; ++j) a += wt[j][i] * x[q + j][i];
                y[i] = a * pg8::sigmoidf_(a) * sc; }
            yk[q][0] = pg8::cvt_pk_bf16(y[0], y[1]); yk[q][1] = pg8::cvt_pk_bf16(y[2], y[3]); yk[q][2] = pg8::cvt_pk_bf16(y[4], y[5]); yk[q][3] = pg8::cvt_pk_bf16(y[6], y[7]);
            const u32x4_t w = {yk[q][0], yk[q][1], yk[q][2], yk[q][3]};
            if (!half) *(u32x4_t*)(cq + (row0 + q) * 512 + c8) = w; else *(u32x4_t*)(ck + (row0 + q) * 512 + c8) = w; }
        if (half) {
            const int hh = c8 >> 6, d0 = c8 & 63;
#pragma unroll
            for (int i = 0; i < 8; ++i) { u32x4_t o;
                const int wsel = i >> 1;
#define KT_PICK(q) ((i & 1) ? (yk[q][wsel] >> 16) : (yk[q][wsel] & 0xffffu))
                o.x = KT_PICK(0) | (KT_PICK(1) << 16); o.y = KT_PICK(2) | (KT_PICK(3) << 16); o.z = KT_PICK(4) | (KT_PICK(5) << 16); o.w = KT_PICK(6) | (KT_PICK(7) << 16);
#undef KT_PICK
                *(u32x4_t*)(Kt + (size_t)((b * 8 + hh) * 64 + d0 + i) * SEQ + t0) = o; }
        }
}
__device__ __forceinline__ void ph_thin(const Params& p, int layer, int bid, int nblk, char* lds) {
    const int tid = tid_l(); const int wid = tid >> 6, lane = tid & 63;
    bf16_t* P = (bf16_t*)(p.ws + WS_P);
    const float* c1 = (const float*)(p.ws + WS_ROPE1); const float* s1 = c1 + SEQ * 64;
    const float* ca = (const float*)(p.ws + WS_ROPEAX); const float* sa = ca + 64 * 32;
    { unsigned long long* st = (unsigned long long*)(p.ws + WS_STATS); for (int i = bid * 512 + tid; i < 2 * MTOK; i += nblk * 512) st[i] = 0ull; }
    { const int j = lane & 7, sub = lane >> 3; constexpr int NIG = MTOK * 22 / 8; const int stride = nblk * 8;
      int ig = bid * 8 + wid;
      QkItem qa; qk_load(qa, p, layer, P, c1, s1, ca, sa, (ig < NIG ? ig : 0) * 8 + sub, j);
      for (; ig < NIG; ig += stride) {
        QkItem qb; const int ign = ig + stride;
        qk_load(qb, p, layer, P, c1, s1, ca, sa, (ign < NIG ? ign : ig) * 8 + sub, j);
        qk_finish(qa);
        qa = qb;
      }
    }
    bf16_t* Vt = (bf16_t*)(p.ws + WS_VT);
    for (int w = 2048 + bid * 8 + wid; w < 4096; w += nblk * 8) conv_wave_item(p, layer, w, lane);
    for (int item = bid; item < 512; item += nblk) {
        const int half = item >> 8, cidx = item & 255, b = cidx >> 6, pc = cidx & 63;
        const int pg = tid >> 6, c8 = (tid & 63) * 8, ch = half * 512 + c8, t0 = pc * 64 + pg * 8; const size_t row0 = (size_t)b * SEQ + t0;
        unsigned yk[8][4];
#pragma unroll
        for (int q = 0; q < 8; ++q) { const u32x4_t w = *(const u32x4_t*)(P + (row0 + q) * LDP + COL_CV + ch); yk[q][0] = w.x; yk[q][1] = w.y; yk[q][2] = w.z; yk[q][3] = w.w; }
        const int hh = ch >> 7, v0 = ch & 127;
#pragma unroll
        for (int i = 0; i < 8; ++i) { u32x4_t o; const int wsel = i >> 1;
#define VT_PICK(q) ((i & 1) ? (yk[q][wsel] >> 16) : (yk[q][wsel] & 0xffffu))
            o.x = VT_PICK(0) | (VT_PICK(1) << 16); o.y = VT_PICK(2) | (VT_PICK(3) << 16); o.z = VT_PICK(4) | (VT_PICK(5) << 16); o.w = VT_PICK(6) | (VT_PICK(7) << 16);
#undef VT_PICK
            *(u32x4_t*)(Vt + (size_t)((b * 8 + hh) * 128 + v0 + i) * SEQ + t0) = o; }
    }
}

__device__ __forceinline__ float log_sigmoid(float x) { return fminf(x, 0.f) - log1pf(__expf(-fabsf(x))); }
__device__ __forceinline__ float scan_add64(float s, int lane) {
#pragma unroll
    for (int o = 1; o < 64; o <<= 1) { const float n = __shfl_up(s, o); if (lane >= o) s += n; }
    return s;
}
__device__ __forceinline__ float scan_max64(float s, int lane) {
#pragma unroll
    for (int o = 1; o < 64; o <<= 1) { const float n = __shfl_up(s, o); if (lane >= o) s = fmaxf(s, n); }
    return s;
}
__device__ __forceinline__ void ph_gatescan(const Params& p, int layer, int bid, int nblk, char* lds) {
    const int tid = tid_l(); const int wid = tid >> 6, lane = tid & 63;
    const float* G = (const float*)(p.ws + WS_GATES); const float* gb = p.c_gate_b + layer * 32;
    float* gA = (float*)(p.ws + WS_GA); float* gM = (float*)(p.ws + WS_GM); float* gF = (float*)(p.ws + WS_GF);
    float* wt = (float*)lds;
    for (int sq = bid; sq < 64; sq += nblk) {
        const int dir = sq & 1, h = (sq >> 1) & 7, b = sq >> 4;
        const int ci = (2 * dir) * 8 + h, cf = (2 * dir + 1) * 8 + h;
        const float bi = gb[ci], bfb = gb[cf];
        float F[8], a[8];
#pragma unroll
        for (int k = 0; k < 8; ++k) { const int idx = tid * 8 + k, pos = dir ? SEQ - 1 - idx : idx; const size_t gr = (size_t)(b * SEQ + pos) * 32; F[k] = G[gr + cf]; a[k] = G[gr + ci]; }
        float run = 0.f;
#pragma unroll
        for (int k = 0; k < 8; ++k) { run += log_sigmoid(F[k] + bfb); F[k] = run; }
        const float inc = scan_add64(run, lane);
        __syncthreads();
        if (lane == 63) wt[wid] = inc;
        __syncthreads();
        float off = inc - run;
#pragma unroll
        for (int w = 0; w < 8; ++w) if (w < wid) off += wt[w];
        float mx = -1e30f;
#pragma unroll
        for (int k = 0; k < 8; ++k) { F[k] += off; a[k] = (a[k] + bi) - F[k]; mx = fmaxf(mx, a[k]); }
        const float incm = scan_max64(mx, lane);
        if (lane == 63) wt[8 + wid] = incm;
        __syncthreads();
        float carry = __shfl_up(incm, 1); if (lane == 0) carry = 0.f;
        carry = fmaxf(carry, 0.f);
#pragma unroll
        for (int w = 0; w < 8; ++w) if (w < wid) carry = fmaxf(carry, wt[8 + w]);
        float M[8];
#pragma unroll
        for (int k = 0; k < 8; ++k) { carry = fmaxf(carry, a[k]); M[k] = carry; }
        const size_t o = (size_t)sq * SEQ + tid * 8;
        *(f32x4_t*)(gF + o) = (f32x4_t){F[0], F[1], F[2], F[3]}; *(f32x4_t*)(gF + o + 4) = (f32x4_t){F[4], F[5], F[6], F[7]};
        *(f32x4_t*)(gA + o) = (f32x4_t){a[0], a[1], a[2], a[3]}; *(f32x4_t*)(gA + o + 4) = (f32x4_t){a[4], a[5], a[6], a[7]};
        *(f32x4_t*)(gM + o) = (f32x4_t){M[0], M[1], M[2], M[3]}; *(f32x4_t*)(gM + o + 4) = (f32x4_t){M[4], M[5], M[6], M[7]};
    }
}

namespace att {
using bf16x8 = __attribute__((ext_vector_type(8))) short;
using s16x4  = __attribute__((ext_vector_type(4))) short;
using f32x16 = __attribute__((ext_vector_type(16))) float;
using u32x4  = __attribute__((ext_vector_type(4))) unsigned;
constexpr int D = 128, NW = 8, QBLK = 32, KVBLK = 64;
constexpr float SCALE = 0.088388347648318440f;
constexpr float THR = 8.f;
constexpr size_t SHM_V = KVBLK * D * 2, SHM_K = KVBLK * D * 2, SHM_ATTN = 2 * SHM_V + 2 * SHM_K + NW * 64 * 4;
#define KSWZ(row, colB) ((row) * 256 + ((colB) ^ (((row) & 7) << 4)))
#define SBAR() __builtin_amdgcn_sched_barrier(0)
__device__ __forceinline__ int crow(int r, int hi) { return (r & 3) + 8 * (r >> 2) + 4 * hi; }
__device__ __forceinline__ unsigned cvtpk(float lo, float hi) { unsigned r; asm volatile("v_cvt_pk_bf16_f32 %0, %1, %2" : "=v"(r) : "v"(lo), "v"(hi)); return r; }

__device__ __forceinline__ void partialSM(f32x16& p0, f32x16& p1, float& m_reg, float& mn, float& alpha) {
  constexpr float C = SCALE * 1.4426950408889634f;
  float pmax = p0[0]; for (int r = 1; r < 16; ++r) pmax = fmaxf(pmax, p0[r]); for (int r = 0; r < 16; ++r) pmax = fmaxf(pmax, p1[r]);
  { auto rr = __builtin_amdgcn_permlane32_swap(__float_as_uint(pmax), __float_as_uint(pmax), false, false);
    pmax = fmaxf(__uint_as_float(rr[0]), __uint_as_float(rr[1])); }
  if (__builtin_expect(__all(pmax - m_reg <= THR / SCALE), 1)) { mn = m_reg; alpha = 1.f; }
  else { mn = fmaxf(m_reg, pmax); alpha = __builtin_amdgcn_exp2f((m_reg - mn) * C); m_reg = mn; }
  float mnC = -mn * C;
  for (int r = 0; r < 16; ++r) p0[r] = fmaf(p0[r], C, mnC); for (int r = 0; r < 16; ++r) p1[r] = fmaf(p1[r], C, mnC);
  for (int r = 0; r < 16; ++r) p0[r] = __builtin_amdgcn_exp2f(p0[r]);
}
__device__ __forceinline__ void finishSM(f32x16& p0, f32x16& p1, float alpha, float& l_reg, bf16x8& pa0, bf16x8& pa1, bf16x8& pa2, bf16x8& pa3) {
  for (int r = 0; r < 16; ++r) p1[r] = __builtin_amdgcn_exp2f(p1[r]);
  float ps = 0; for (int r = 0; r < 16; ++r) ps += p0[r]; for (int r = 0; r < 16; ++r) ps += p1[r];
  { auto rr = __builtin_amdgcn_permlane32_swap(__float_as_uint(ps), __float_as_uint(ps), false, false);
    ps = __uint_as_float(rr[0]) + __uint_as_float(rr[1]); }
  l_reg = l_reg * alpha + ps;
#define PK4(P, BASE, OUT) do { unsigned a0 = cvtpk(P[BASE + 0], P[BASE + 1]), a1 = cvtpk(P[BASE + 2], P[BASE + 3]);   \
    unsigned b0 = cvtpk(P[BASE + 4], P[BASE + 5]), b1 = cvtpk(P[BASE + 6], P[BASE + 7]);                              \
    auto r0 = __builtin_amdgcn_permlane32_swap(a0, b0, false, false); auto r1 = __builtin_amdgcn_permlane32_swap(a1, b1, false, false); \
    u32x4 w = {r0[0], r1[0], r0[1], r1[1]}; OUT = *reinterpret_cast<bf16x8*>(&w); } while (0)
  PK4(p0, 0, pa0); PK4(p0, 8, pa1); PK4(p1, 0, pa2); PK4(p1, 8, pa3);
#undef PK4
}
__device__ __forceinline__ void qkt(f32x16& p0, f32x16& p1, const bf16_t* Ks, const bf16x8* qr, int r32, int hi) {
  p0 = f32x16{}; p1 = f32x16{};
  for (int d0 = 0; d0 < 8; ++d0) { int cb = (d0 * 16 + hi * 8) * 2;
    bf16x8 b0 = *reinterpret_cast<const bf16x8*>((const char*)Ks + KSWZ(r32, cb));
    bf16x8 b1 = *reinterpret_cast<const bf16x8*>((const char*)Ks + KSWZ(32 + r32, cb));
    p0 = __builtin_amdgcn_mfma_f32_32x32x16_bf16(b0, qr[d0], p0, 0, 0, 0);
    p1 = __builtin_amdgcn_mfma_f32_32x32x16_bf16(b1, qr[d0], p1, 0, 0, 0); }
}
__device__ __forceinline__ void maskband(f32x16& p0, f32x16& p1, int kb_minus_qi, int hi) {
  const float ninf = -__builtin_inff();
#pragma unroll
  for (int r = 0; r < 16; ++r) { const int d0 = kb_minus_qi + crow(r, hi);
    p0[r] = ((unsigned)(d0 + 64) <= 128u) ? p0[r] : ninf; p1[r] = ((unsigned)(d0 + 32 + 64) <= 128u) ? p1[r] : ninf; }
}
__device__ __forceinline__ int v_st(int k, int c) { const int kk = (k & ~0xC) | ((k & 4) << 1) | ((k & 8) >> 1); return ((kk >> 3) * 4 + (c >> 5)) * 512 + ((kk & 7) * 32 + (c & 31)) * 2; }
__device__ __forceinline__ int v_rd_base(int lane) { return ((lane & 3) << 3) | (((lane >> 2) & 3) << 6) | (((lane >> 4) & 1) << 5) | (((lane >> 5) & 1) << 8); }
constexpr int v_rd_off(int d0, int ks, int half) { return d0 * 512 + ks * 4096 + half * 2048; }
template <int OFF> __device__ __forceinline__ s16x4 tr_read(int vb) {
  s16x4 r; asm volatile("ds_read_b64_tr_b16 %0, %1 offset:%2" : "=&v"(r) : "v"(vb), "i"(OFF) : "memory"); return r;
}
template <int D0> __device__ __forceinline__ void pv_one(f32x16& od, int vb, bf16x8 pa0, bf16x8 pa1, bf16x8 pa2, bf16x8 pa3) {
  const s16x4 l0 = tr_read<v_rd_off(D0, 0, 0)>(vb), h0 = tr_read<v_rd_off(D0, 0, 1)>(vb), l1 = tr_read<v_rd_off(D0, 1, 0)>(vb), h1 = tr_read<v_rd_off(D0, 1, 1)>(vb);
  const s16x4 l2 = tr_read<v_rd_off(D0, 2, 0)>(vb), h2 = tr_read<v_rd_off(D0, 2, 1)>(vb), l3 = tr_read<v_rd_off(D0, 3, 0)>(vb), h3 = tr_read<v_rd_off(D0, 3, 1)>(vb);
  asm volatile("s_waitcnt lgkmcnt(0)" ::: "memory"); SBAR();
#define PK(L, H) (bf16x8){L[0], L[1], L[2], L[3], H[0], H[1], H[2], H[3]}
  od = __builtin_amdgcn_mfma_f32_32x32x16_bf16(pa0, PK(l0, h0), od, 0, 0, 0);
  od = __builtin_amdgcn_mfma_f32_32x32x16_bf16(pa1, PK(l1, h1), od, 0, 0, 0);
  od = __builtin_amdgcn_mfma_f32_32x32x16_bf16(pa2, PK(l2, h2), od, 0, 0, 0);
  od = __builtin_amdgcn_mfma_f32_32x32x16_bf16(pa3, PK(l3, h3), od, 0, 0, 0);
#undef PK
}
__device__ __forceinline__ void pv_d0(f32x16* o, int vb, bf16x8 pa0, bf16x8 pa1, bf16x8 pa2, bf16x8 pa3) {
  pv_one<0>(o[0], vb, pa0, pa1, pa2, pa3); pv_one<1>(o[1], vb, pa0, pa1, pa2, pa3); pv_one<2>(o[2], vb, pa0, pa1, pa2, pa3); pv_one<3>(o[3], vb, pa0, pa1, pa2, pa3);
}

template <bool BAND, int SDEPTH>
__device__ __forceinline__ void attn_body(const bf16_t* __restrict__ Qb, long ldq, const bf16_t* __restrict__ Kh, const bf16_t* __restrict__ Vh, long ldk,
                                          bf16_t* __restrict__ Ob, long ldo, float* __restrict__ lse_out, long ld_lse, int qi0, int kt0, int NT, char* lds) {
  const int tid = tid_l(), wid = tid >> 6, lane = tid & 63, r32 = lane & 31, hi = lane >> 5;
  bf16_t* V_lds = (bf16_t*)lds; bf16_t* K_lds = (bf16_t*)(lds + 2 * SHM_V);
  float* wsm = (float*)(lds + 2 * SHM_V + 2 * SHM_K) + wid * 64; float* li_l = wsm; float* al_l = wsm + 32;
  float m_reg = -1e30f, l_reg = 0; f32x16 o[4] = {}; bf16x8 qr[8];
  const bf16_t* Qw = Qb + (long)(wid * QBLK + r32) * ldq + hi * 8;
#pragma unroll
  for (int d0 = 0; d0 < 8; ++d0) qr[d0] = *reinterpret_cast<const bf16x8*>(Qw + d0 * 16);
  const int sr = tid >> 4, sc = (tid & 15) * 8, vst0 = v_st(sr, sc), vst1 = v_st(32 + sr, sc);
  const int vb0 = (int)(uintptr_t)V_lds + v_rd_base(lane);
  const int qi = qi0 + wid * QBLK + r32;
  struct { bf16x8 vs0, vs1, ks0, ks1; } sr_[SDEPTH] = {};
  const bf16_t* Kt = Kh + (long)(kt0 * KVBLK) * ldk; const bf16_t* Vt = Vh + (long)(kt0 * KVBLK) * ldk;
#define SLOAD(i, k0) do { sr_[i].vs0 = *reinterpret_cast<const bf16x8*>(&Vt[(long)((k0) + sr) * ldk + sc]); sr_[i].vs1 = *reinterpret_cast<const bf16x8*>(&Vt[(long)((k0) + 32 + sr) * ldk + sc]); \
    sr_[i].ks0 = *reinterpret_cast<const bf16x8*>(&Kt[(long)((k0) + sr) * ldk + sc]); sr_[i].ks1 = *reinterpret_cast<const bf16x8*>(&Kt[(long)((k0) + 32 + sr) * ldk + sc]); } while (0)
#define SWRITE(b, i) do { *(bf16x8*)((char*)V_lds + (b) * SHM_V + vst0) = sr_[i].vs0;          \
    *(bf16x8*)((char*)V_lds + (b) * SHM_V + vst1) = sr_[i].vs1; int kc = sc * 2;               \
    *(bf16x8*)((char*)K_lds + (b) * SHM_K + KSWZ(sr, kc)) = sr_[i].ks0;                       \
    *(bf16x8*)((char*)K_lds + (b) * SHM_K + KSWZ(32 + sr, kc)) = sr_[i].ks1; } while (0)
#define SWAIT() do { if constexpr (SDEPTH == 2) asm volatile("s_waitcnt vmcnt(4)" ::: "memory"); else asm volatile("s_waitcnt vmcnt(0)" ::: "memory"); } while (0)
#define RESC(a) do { if (__any((a) < 1.f)) { if (hi == 0) al_l[r32] = (a); asm volatile("s_waitcnt lgkmcnt(0)" ::: "memory"); \
    for (int d = 0; d < 4; ++d) for (int r = 0; r < 16; ++r) o[d][r] *= al_l[crow(r, hi)]; } } while (0)
#define MASK(P0, P1, j) do { if (BAND) maskband(P0, P1, (kt0 + (j)) * KVBLK - qi, hi); } while (0)
  f32x16 pA0 = {}, pA1 = {}, pB0 = {}, pB1 = {}; float mnA = 0.f, mnB = 0.f, alA = 1.f, alB = 1.f; bf16x8 pa0 = {}, pa1 = {}, pa2 = {}, pa3 = {};
  constexpr int SE = 0, SO = SDEPTH - 1;
  __syncthreads();
  SLOAD(SE, 0); asm volatile("s_waitcnt vmcnt(0)" ::: "memory"); SWRITE(0, SE); __syncthreads();
  qkt(pA0, pA1, K_lds, qr, r32, hi); MASK(pA0, pA1, 0); partialSM(pA0, pA1, m_reg, mnA, alA);
  SLOAD(SO, KVBLK); if constexpr (SDEPTH == 2) { if (2 < NT) SLOAD(SE, 2 * KVBLK); }
  SWAIT(); SWRITE(1, SO); __syncthreads();
  for (int j = 1; j + 1 < NT; j += 2) {
    SBAR(); qkt(pB0, pB1, (bf16_t*)((char*)K_lds + SHM_K), qr, r32, hi); MASK(pB0, pB1, j);
    finishSM(pA0, pA1, alA, l_reg, pa0, pa1, pa2, pa3); SBAR();
    SLOAD(SO, (j + SDEPTH) * KVBLK); SBAR();
    pv_d0(o, vb0, pa0, pa1, pa2, pa3); partialSM(pB0, pB1, m_reg, mnB, alB);
    __syncthreads(); SWAIT(); SWRITE(0, SE);
    RESC(alB); __syncthreads();
    SBAR(); qkt(pA0, pA1, K_lds, qr, r32, hi); MASK(pA0, pA1, j + 1);
    finishSM(pB0, pB1, alB, l_reg, pa0, pa1, pa2, pa3); SBAR();
    if (SDEPTH == 1 || j + 3 < NT) SLOAD(SE, (j + 1 + SDEPTH) * KVBLK); SBAR();
    pv_d0(o, vb0 + (int)SHM_V, pa0, pa1, pa2, pa3); partialSM(pA0, pA1, m_reg, mnA, alA);
    __syncthreads(); SWAIT(); SWRITE(1, SO);
    RESC(alA); __syncthreads();
  }
  SBAR(); qkt(pB0, pB1, (bf16_t*)((char*)K_lds + SHM_K), qr, r32, hi); MASK(pB0, pB1, NT - 1);
  finishSM(pA0, pA1, alA, l_reg, pa0, pa1, pa2, pa3); SBAR();
  pv_d0(o, vb0, pa0, pa1, pa2, pa3); partialSM(pB0, pB1, m_reg, mnB, alB);
  __syncthreads(); RESC(alB);
  finishSM(pB0, pB1, alB, l_reg, pa0, pa1, pa2, pa3); SBAR();
  pv_d0(o, vb0 + (int)SHM_V, pa0, pa1, pa2, pa3);
  if (hi == 0) li_l[r32] = l_reg; asm volatile("s_waitcnt lgkmcnt(0)" ::: "memory");
  if (BAND) { if (hi == 0) lse_out[(long)(wid * QBLK + r32) * ld_lse] = m_reg * SCALE + __logf(l_reg); }
  float rli[16];
#pragma unroll
  for (int r = 0; r < 16; ++r) rli[r] = __builtin_amdgcn_rcpf(li_l[crow(r, hi)]);
  bf16_t* Ow = Ob + (long)(wid * QBLK) * ldo;
#pragma unroll
  for (int r = 0; r < 16; ++r) { int orow = crow(r, hi);
    for (int d0 = 0; d0 < 4; ++d0) Ow[(long)orow * ldo + d0 * 32 + r32] = (bf16_t)(cvtpk(o[d0][r] * rli[r], 0.f) & 0xffffu); }
#undef SLOAD
#undef SWRITE
#undef SWAIT
#undef RESC
#undef MASK
}
#undef KSWZ
#undef SBAR
}

__device__ __forceinline__ void ph_attn_b(const Params& p, int layer, int bid, int nblk, char* lds) {
    const bf16_t* P = (const bf16_t*)(p.ws + WS_P); bf16_t* YB = (bf16_t*)(p.ws + WS_YA)  ;
    for (int u = bid; u < 512; u += nblk) {
        const int g = u & 3, qb = (u >> 2) & 15, kvh = (u >> 6) & 1, b = u >> 7, hq = kvh * 4 + g;
        const bf16_t* Qb = P + (size_t)(b * SEQ + qb * 256) * LDP + COL_BQ + hq * 128;
        const bf16_t* Kh = P + (size_t)(b * SEQ) * LDP + COL_BK + kvh * 128; const bf16_t* Vh = P + (size_t)(b * SEQ) * LDP + COL_BV + kvh * 128;
        att::attn_body<false, 2>(Qb, LDP, Kh, Vh, LDP, YB + (size_t)(b * SEQ + qb * 256) * YK + 768 + hq * 128, YK, nullptr, 0, 0, 0, SEQ / 64, lds);
    }
}
__device__ __forceinline__ void ph_attn_a(const Params& p, int layer, int bid, int nblk, char* lds) {
    const bf16_t* P = (const bf16_t*)(p.ws + WS_P);
    for (int u = bid; u < 1152; u += nblk) {
        const int sub = u % 48, bh = u / 48, h = bh % 6, b = bh / 6;
        int g, r, qb; if (sub < 16) { g = 0; r = 0; qb = sub; } else if (sub < 32) { g = 1; r = (sub - 16) >> 2; qb = (sub - 16) & 3; } else { g = 2; r = sub - 32; qb = 0; }
        const int d = g == 0 ? 1 : (g == 1 ? 4 : 16), L = SEQ / d, NT = L >= 384 ? 6 : 4, l0 = qb * 256;
        int kt0 = qb * 4 - 1; if (kt0 < 0) kt0 = 0; if (kt0 > L / 64 - NT) kt0 = L / 64 - NT;
        const size_t row0 = (size_t)(b * SEQ + l0 * d + r), rowk = (size_t)(b * SEQ + r);
        bf16_t* OA = (bf16_t*)(p.ws + WS_OA) + (size_t)g * MTOK * 768; float* LS = (float*)(p.ws + WS_LSE) + (size_t)g * MTOK * 6;
        att::attn_body<true, 1>(P + row0 * LDP + COL_AQ + h * 128, (long)d * LDP, P + rowk * LDP + COL_AK + h * 128, P + rowk * LDP + COL_AV + h * 128, (long)d * LDP,
                             OA + row0 * 768 + h * 128, (long)d * 768, LS + row0 * 6 + h, (long)d * 6, l0, kt0, NT, lds);
    }
}
struct AmIn { float l0, l1, l2; u32x4_t a, b, c; };
__device__ __forceinline__ void am_load(AmIn& x, const bf16_t* OA, const float* LS, int item) {
    const int row = item / 96, c8 = (item % 96) * 8, h = c8 >> 7;
    x.l0 = LS[(size_t)row * 6 + h]; x.l1 = LS[(size_t)MTOK * 6 + (size_t)row * 6 + h]; x.l2 = LS[(size_t)2 * MTOK * 6 + (size_t)row * 6 + h];
    x.a = *(const u32x4_t*)(OA + (size_t)row * 768 + c8); x.b = *(const u32x4_t*)(OA + (size_t)MTOK * 768 + (size_t)row * 768 + c8); x.c = *(const u32x4_t*)(OA + (size_t)2 * MTOK * 768 + (size_t)row * 768 + c8);
}
__device__ __forceinline__ void am_finish(const AmIn& x, bf16_t* YA, int item) {
    const int row = item / 96, c8 = (item % 96) * 8;
    const float mx = fmaxf(x.l0, fmaxf(x.l1, x.l2)); float w0 = __expf(x.l0 - mx), w1 = __expf(x.l1 - mx), w2 = __expf(x.l2 - mx); const float inv = __builtin_amdgcn_rcpf(w0 + w1 + w2); w0 *= inv; w1 *= inv; w2 *= inv;
    const u32x4_t a = x.a, bq = x.b, cq = x.c;
    u32x4_t w;
    w.x = pg8::cvt_pk_bf16(w0 * pg8::bf_lo(a.x) + w1 * pg8::bf_lo(bq.x) + w2 * pg8::bf_lo(cq.x), w0 * pg8::bf_hi(a.x) + w1 * pg8::bf_hi(bq.x) + w2 * pg8::bf_hi(cq.x));
    w.y = pg8::cvt_pk_bf16(w0 * pg8::bf_lo(a.y) + w1 * pg8::bf_lo(bq.y) + w2 * pg8::bf_lo(cq.y), w0 * pg8::bf_hi(a.y) + w1 * pg8::bf_hi(bq.y) + w2 * pg8::bf_hi(cq.y));
    w.z = pg8::cvt_pk_bf16(w0 * pg8::bf_lo(a.z) + w1 * pg8::bf_lo(bq.z) + w2 * pg8::bf_lo(cq.z), w0 * pg8::bf_hi(a.z) + w1 * pg8::bf_hi(bq.z) + w2 * pg8::bf_hi(cq.z));
    w.w = pg8::cvt_pk_bf16(w0 * pg8::bf_lo(a.w) + w1 * pg8::bf_lo(bq.w) + w2 * pg8::bf_lo(cq.w), w0 * pg8::bf_hi(a.w) + w1 * pg8::bf_hi(bq.w) + w2 * pg8::bf_hi(cq.w));
    *(u32x4_t*)(YA + (size_t)row * YK + c8) = w;
}
constexpr int AM_TILES = MTOK * 96 / 192;
__device__ __forceinline__ void amerge_wave_tile(const Params& p, int wt, int lane) {
    const bf16_t* OA = (const bf16_t*)(p.ws + WS_OA); const float* LS = (const float*)(p.ws + WS_LSE); bf16_t* YA = (bf16_t*)(p.ws + WS_YA);
    const int i0 = wt * 192 + lane;
    AmIn x0, x1, x2;
    am_load(x0, OA, LS, i0); am_load(x1, OA, LS, i0 + 64); am_load(x2, OA, LS, i0 + 128);
    am_finish(x0, YA, i0); am_finish(x1, YA, i0 + 64); am_finish(x2, YA, i0 + 128);
}

namespace ml {
using att::bf16x8; using att::f32x16; using att::u32x4; using att::cvtpk; using att::crow;
__device__ __forceinline__ float swap_add(float v) { auto rr = __builtin_amdgcn_permlane32_swap(__float_as_uint(v), __float_as_uint(v), false, false); return __uint_as_float(rr[0]) + __uint_as_float(rr[1]); }
__device__ __forceinline__ float from_lower(float v) { auto rr = __builtin_amdgcn_permlane32_swap(__float_as_uint(v), __float_as_uint(v), false, false); return __uint_as_float(rr[0]); }
__device__ __forceinline__ bf16x8 scale_frag(bf16x8 f, float s) {
    const u32x4 w = *reinterpret_cast<const u32x4*>(&f); u32x4 o;
    o.x = cvtpk(pg8::bf_lo(w.x) * s, pg8::bf_hi(w.x) * s); o.y = cvtpk(pg8::bf_lo(w.y) * s, pg8::bf_hi(w.y) * s);
    o.z = cvtpk(pg8::bf_lo(w.z) * s, pg8::bf_hi(w.z) * s); o.w = cvtpk(pg8::bf_lo(w.w) * s, pg8::bf_hi(w.w) * s);
    return *reinterpret_cast<const bf16x8*>(&o);
}
__device__ __forceinline__ bf16x8 weight_frag(bf16x8 f, f32x4_t wa, f32x4_t wb, float& acc) {
    const u32x4 w = *reinterpret_cast<const u32x4*>(&f);
    const float e0 = pg8::bf_lo(w.x) * wa[0], e1 = pg8::bf_hi(w.x) * wa[1], e2 = pg8::bf_lo(w.y) * wa[2], e3 = pg8::bf_hi(w.y) * wa[3];
    const float e4 = pg8::bf_lo(w.z) * wb[0], e5 = pg8::bf_hi(w.z) * wb[1], e6 = pg8::bf_lo(w.w) * wb[2], e7 = pg8::bf_hi(w.w) * wb[3];
    acc += ((e0 + e1) + (e2 + e3)) + ((e4 + e5) + (e6 + e7));
    u32x4 o; o.x = cvtpk(e0, e1); o.y = cvtpk(e2, e3); o.z = cvtpk(e4, e5); o.w = cvtpk(e6, e7);
    return *reinterpret_cast<const bf16x8*>(&o);
}
__device__ __forceinline__ bf16_t bf1(float v) { unsigned u = __float_as_uint(v); u += 0x7fffu + ((u >> 16) & 1u); return (bf16_t)(u >> 16); }

__device__ __forceinline__ void ph_ml_state(const Params& p, int bid, int nblk) {
    const int tid = tid_l(); const int wid = tid >> 6, lane = tid & 63, l32 = lane & 31, hi = lane >> 5;
    const bf16_t* Kt = (const bf16_t*)(p.ws + WS_KT); const bf16_t* Vt = (const bf16_t*)(p.ws + WS_VT);
    const float* gA = (const float*)(p.ws + WS_GA); const float* gM = (const float*)(p.ws + WS_GM);
    bf16_t* SB = (bf16_t*)(p.ws + WS_SBUF); bf16_t* NBf = (bf16_t*)(p.ws + WS_NBUF);
    for (int wu = bid * 8 + wid; wu < 2048; wu += nblk * 8) {
        const int pc = wu & 63, h = (wu >> 6) & 7, b = wu >> 9, bh = b * 8 + h, sqf = bh * 2, sqb = sqf + 1, cb = 63 - pc, pos0 = pc * 64;
        const float mend_f = gM[sqf * SEQ + pos0 + 63], mend_b = gM[sqb * SEQ + cb * 64 + 63];
        bf16x8 kwf[2][4], kwb[2][4]; float nf[2] = {0.f, 0.f}, nb[2] = {0.f, 0.f};
#pragma unroll
        for (int ks = 0; ks < 4; ++ks) {
            const int j0 = 16 * ks + 8 * hi;
            f32x4_t wfa = *(const f32x4_t*)(gA + sqf * SEQ + pos0 + j0), wfb = *(const f32x4_t*)(gA + sqf * SEQ + pos0 + j0 + 4);
            const float* gb = gA + sqb * SEQ + (SEQ - 1 - (pos0 + j0 + 7));
            const f32x4_t t0 = *(const f32x4_t*)(gb), t1 = *(const f32x4_t*)(gb + 4);
            f32x4_t wba = {t1[3], t1[2], t1[1], t1[0]}, wbb = {t0[3], t0[2], t0[1], t0[0]};
#pragma unroll
            for (int i = 0; i < 4; ++i) { wfa[i] = __expf(wfa[i] - mend_f); wfb[i] = __expf(wfb[i] - mend_f); wba[i] = __expf(wba[i] - mend_b); wbb[i] = __expf(wbb[i] - mend_b); }
#pragma unroll
            for (int dt = 0; dt < 2; ++dt) { const bf16x8 kf = *(const bf16x8*)(Kt + (size_t)(bh * 64 + dt * 32 + l32) * SEQ + pos0 + j0);
                kwf[dt][ks] = weight_frag(kf, wfa, wfb, nf[dt]); kwb[dt][ks] = weight_frag(kf, wba, wbb, nb[dt]); }
        }
#pragma unroll
        for (int dt = 0; dt < 2; ++dt) { const float a = swap_add(nf[dt]), c = swap_add(nb[dt]);
            if (hi == 0) { NBf[(size_t)(sqf * 64 + pc) * 64 + dt * 32 + l32] = bf1(a); NBf[(size_t)(sqb * 64 + cb) * 64 + dt * 32 + l32] = bf1(c); } }
#pragma unroll 1
        for (int vt = 0; vt < 4; ++vt) {
            f32x16 accf[2] = {}, accb[2] = {};
#pragma unroll
            for (int ks = 0; ks < 4; ++ks) { const bf16x8 vf = *(const bf16x8*)(Vt + (size_t)(bh * 128 + vt * 32 + l32) * SEQ + pos0 + 16 * ks + 8 * hi);
#pragma unroll
                for (int dt = 0; dt < 2; ++dt) { accf[dt] = __builtin_amdgcn_mfma_f32_32x32x16_bf16(vf, kwf[dt][ks], accf[dt], 0, 0, 0); accb[dt] = __builtin_amdgcn_mfma_f32_32x32x16_bf16(vf, kwb[dt][ks], accb[dt], 0, 0, 0); } }
            bf16_t* sf = SB + ((size_t)(sqf * 64 + pc) * 128 + vt * 32) * 64; bf16_t* sb = SB + ((size_t)(sqb * 64 + cb) * 128 + vt * 32) * 64;
#pragma unroll
            for (int dt = 0; dt < 2; ++dt)
#pragma unroll
                for (int r = 0; r < 16; ++r) { sf[crow(r, hi) * 64 + dt * 32 + l32] = bf1(accf[dt][r]); sb[crow(r, hi) * 64 + dt * 32 + l32] = bf1(accb[dt][r]); }
        }
    }
}

__device__ __forceinline__ void ph_ml_scan(const Params& p, int bid, int nblk) {
    const float* gM = (const float*)(p.ws + WS_GM);
    const int tid = tid_l();
    for (int item = bid * 512 + tid; item < 64 * 2064; item += nblk * 512) {
        const bool isS = item < 64 * 2048; const int sq = isS ? (item >> 11) : ((item - 64 * 2048) >> 4), e = isS ? (item & 2047) : ((item - 64 * 2048) & 15);
        bf16_t* base; size_t stride;
        if (isS) { base = (bf16_t*)(p.ws + WS_SBUF) + (size_t)sq * 64 * 8192 + e * 4; stride = 8192; } else { base = (bf16_t*)(p.ws + WS_NBUF) + (size_t)sq * 64 * 64 + e * 4; stride = 64; }
        float a0 = 0.f, a1 = 0.f, a2 = 0.f, a3 = 0.f, mprev = 0.f;
#pragma unroll 1
        for (int g = 0; g < 4; ++g) {
            u32x2_t buf[16]; float mend[16];
#pragma unroll
            for (int k = 0; k < 16; ++k) { buf[k] = *(const u32x2_t*)(base + (size_t)(g * 16 + k) * stride); mend[k] = gM[sq * SEQ + (g * 16 + k) * 64 + 63]; }
#pragma unroll
            for (int k = 0; k < 16; ++k) {
                const float dec = __expf(mprev - mend[k]); mprev = mend[k];
                u32x2_t o; o.x = pg8::cvt_pk_bf16(a0, a1); o.y = pg8::cvt_pk_bf16(a2, a3);
                *(u32x2_t*)(base + (size_t)(g * 16 + k) * stride) = o;
                a0 = dec * a0 + pg8::bf_lo(buf[k].x); a1 = dec * a1 + pg8::bf_hi(buf[k].x); a2 = dec * a2 + pg8::bf_lo(buf[k].y); a3 = dec * a3 + pg8::bf_hi(buf[k].y);
            }
        }
    }
}

constexpr int OUT_LDS_PER_WAVE = (128 + 32 * 65) * 4;
__device__ __forceinline__ void ph_ml_out(const Params& p, int layer, int bid, int nblk, char* lds) {
    const int tid = tid_l(); const int wid = tid >> 6, lane = tid & 63, l32 = lane & 31, hi = lane >> 5;
    float* af = (float*)(lds + wid * OUT_LDS_PER_WAVE); float* ab = af + 64; float* T = af + 128;
    const bf16_t* P = (const bf16_t*)(p.ws + WS_P); const bf16_t* cq = (const bf16_t*)(p.ws + WS_CQ); const bf16_t* ck = (const bf16_t*)(p.ws + WS_CK);
    const bf16_t* Vt = (const bf16_t*)(p.ws + WS_VT); const bf16_t* SB = (const bf16_t*)(p.ws + WS_SBUF); const bf16_t* NBf = (const bf16_t*)(p.ws + WS_NBUF);
    const float* gA = (const float*)(p.ws + WS_GA); const float* gM = (const float*)(p.ws + WS_GM); const float* gF = (const float*)(p.ws + WS_GF);
    bf16_t* YC = (bf16_t*)(p.ws + WS_YA) + 1792  ; const float* og = p.c_out_g + layer * 1024;
    for (int wu = bid * 8 + wid; wu < 4096; wu += nblk * 8) {
        const int th = wu & 1, pc = (wu >> 1) & 63, h = (wu >> 7) & 7, b = wu >> 10, bh = b * 8 + h, sqf = bh * 2, sqb = sqf + 1, cb = 63 - pc, pos0 = pc * 64;
        const size_t rowbase = (size_t)b * SEQ + pos0; const int t = th * 32 + l32;
        asm volatile("s_waitcnt lgkmcnt(0)" ::: "memory");
        af[lane] = gA[sqf * SEQ + pos0 + lane]; ab[lane] = gA[sqb * SEQ + (SEQ - 1 - (pos0 + lane))];
        const int idxb = SEQ - 1 - (pos0 + t);
        const float Mf = gM[sqf * SEQ + pos0 + t], Ff = gF[sqf * SEQ + pos0 + t], Mb = gM[sqb * SEQ + idxb], Fb = gF[sqb * SEQ + idxb];
        const float mpf = pc > 0 ? gM[sqf * SEQ + pos0 - 1] : 0.f, mpb = cb > 0 ? gM[sqb * SEQ + cb * 64 - 1] : 0.f;
        bf16x8 qf[4];
#pragma unroll
        for (int ks = 0; ks < 4; ++ks) qf[ks] = *(const bf16x8*)(cq + (rowbase + t) * 512 + h * 64 + 16 * ks + 8 * hi);
        f32x16 s0 = {}, s1 = {}, sn = {};
#pragma unroll
        for (int ks = 0; ks < 4; ++ks) {
            const bf16x8 k0 = *(const bf16x8*)(ck + (rowbase + l32) * 512 + h * 64 + 16 * ks + 8 * hi), k1 = *(const bf16x8*)(ck + (rowbase + 32 + l32) * 512 + h * 64 + 16 * ks + 8 * hi);
            bf16x8 nfr = {0, 0, 0, 0, 0, 0, 0, 0};
            if (l32 < 2) nfr = *(const bf16x8*)(NBf + (size_t)(l32 == 0 ? (sqf * 64 + pc) : (sqb * 64 + cb)) * 64 + 16 * ks + 8 * hi);
            s0 = __builtin_amdgcn_mfma_f32_32x32x16_bf16(k0, qf[ks], s0, 0, 0, 0); s1 = __builtin_amdgcn_mfma_f32_32x32x16_bf16(k1, qf[ks], s1, 0, 0, 0);
            sn = __builtin_amdgcn_mfma_f32_32x32x16_bf16(nfr, qf[ks], sn, 0, 0, 0);
        }
        const float qnf = from_lower(sn[0]), qnb = from_lower(sn[1]);
        asm volatile("s_waitcnt lgkmcnt(0)" ::: "memory");
        f32x16 b0, b1; float denf = 0.f, denb = 0.f; const float ninf = -__builtin_inff();
#pragma unroll
        for (int r = 0; r < 16; ++r) {
            const int sa = crow(r, hi), sb2 = 32 + crow(r, hi);
            const float ef0 = __expf(sa <= t ? af[sa] - Mf : ninf), eb0 = __expf(sa >= t ? ab[sa] - Mb : ninf);
            const float ef1 = __expf(sb2 <= t ? af[sb2] - Mf : ninf), eb1 = __expf(sb2 >= t ? ab[sb2] - Mb : ninf);
            b0[r] = eb0 * s0[r]; s0[r] = ef0 * s0[r]; b1[r] = eb1 * s1[r]; s1[r] = ef1 * s1[r];
            denf += s0[r] + s1[r]; denb += b0[r] + b1[r];
        }
        denf = swap_add(denf); denb = swap_add(denb);
        const float interf = __expf(mpf - Mf), interb = __expf(mpb - Mb);
        denf += interf * qnf; denb += interb * qnb;
        const float idf = __builtin_amdgcn_rcpf(fmaxf(fabsf(denf), __expf(-(Ff + Mf)))), idb = __builtin_amdgcn_rcpf(fmaxf(fabsf(denb), __expf(-(Fb + Mb))));
#pragma unroll
        for (int r = 0; r < 16; ++r) { s0[r] = s0[r] * idf + b0[r] * idb; s1[r] = s1[r] * idf + b1[r] * idb; }
        bf16x8 pa[4];
#define PK4(PV, BASE, OUT) do { unsigned a0_ = cvtpk(PV[BASE + 0], PV[BASE + 1]), a1_ = cvtpk(PV[BASE + 2], PV[BASE + 3]);   \
    unsigned b0_ = cvtpk(PV[BASE + 4], PV[BASE + 5]), b1_ = cvtpk(PV[BASE + 6], PV[BASE + 7]);                              \
    auto r0_ = __builtin_amdgcn_permlane32_swap(a0_, b0_, false, false); auto r1_ = __builtin_amdgcn_permlane32_swap(a1_, b1_, false, false); \
    u32x4 w_ = {r0_[0], r1_[0], r0_[1], r1_[1]}; OUT = *reinterpret_cast<bf16x8*>(&w_); } while (0)
        PK4(s0, 0, pa[0]); PK4(s0, 8, pa[1]); PK4(s1, 0, pa[2]); PK4(s1, 8, pa[3]);
#undef PK4
        bf16x8 qef[4], qeb[4];
#pragma unroll
        for (int ks = 0; ks < 4; ++ks) { qef[ks] = scale_frag(qf[ks], interf * idf); qeb[ks] = scale_frag(qf[ks], interb * idb); }
        f32x16 o[4] = {};
#pragma unroll
        for (int vt = 0; vt < 4; ++vt) {
#pragma unroll
            for (int ks = 0; ks < 4; ++ks) {
                const bf16x8 vf = *(const bf16x8*)(Vt + (size_t)(bh * 128 + vt * 32 + l32) * SEQ + pos0 + 16 * ks + 8 * hi);
                const bf16x8 cf = *(const bf16x8*)(SB + ((size_t)(sqf * 64 + pc) * 128 + vt * 32 + l32) * 64 + 16 * ks + 8 * hi);
                const bf16x8 cbf = *(const bf16x8*)(SB + ((size_t)(sqb * 64 + cb) * 128 + vt * 32 + l32) * 64 + 16 * ks + 8 * hi);
                o[vt] = __builtin_amdgcn_mfma_f32_32x32x16_bf16(vf, pa[ks], o[vt], 0, 0, 0);
                o[vt] = __builtin_amdgcn_mfma_f32_32x32x16_bf16(cf, qef[ks], o[vt], 0, 0, 0);
                o[vt] = __builtin_amdgcn_mfma_f32_32x32x16_bf16(cbf, qeb[ks], o[vt], 0, 0, 0);
            }
        }
        float ss = 0.f;
#pragma unroll
        for (int vt = 0; vt < 4; ++vt)
#pragma unroll
            for (int r = 0; r < 16; ++r) ss += o[vt][r] * o[vt][r];
        ss = swap_add(ss);
        const float rs = rsqrtf(ss * (1.0f / 128.0f) + EPS);
#pragma unroll
        for (int half = 0; half < 2; ++half) {
            asm volatile("s_waitcnt lgkmcnt(0)" ::: "memory");
#pragma unroll
            for (int v2 = 0; v2 < 2; ++v2)
#pragma unroll
                for (int r = 0; r < 16; ++r) T[l32 * 65 + v2 * 32 + crow(r, hi)] = o[half * 2 + v2][r] * rs;
            asm volatile("s_waitcnt lgkmcnt(0)" ::: "memory");
#pragma unroll
            for (int it = 0; it < 4; ++it) {
                const int item = it * 64 + lane, row = item >> 3, vg = (item & 7) * 8, vcol = h * 128 + half * 64 + vg; const size_t grow = rowbase + th * 32 + row;
                const f32x4_t g0 = *(const f32x4_t*)(og + vcol), g1 = *(const f32x4_t*)(og + vcol + 4);
                const u32x4_t op = *(const u32x4_t*)(P + grow * LDP + COL_CO + vcol);
                float x[8];
#pragma unroll
                for (int i = 0; i < 8; ++i) x[i] = T[row * 65 + vg + i];
                x[0] *= g0[0] * pg8::sigmoidf_(pg8::bf_lo(op.x)); x[1] *= g0[1] * pg8::sigmoidf_(pg8::bf_hi(op.x)); x[2] *= g0[2] * pg8::sigmoidf_(pg8::bf_lo(op.y)); x[3] *= g0[3] * pg8::sigmoidf_(pg8::bf_hi(op.y));
                x[4] *= g1[0] * pg8::sigmoidf_(pg8::bf_lo(op.z)); x[5] *= g1[1] * pg8::sigmoidf_(pg8::bf_hi(op.z)); x[6] *= g1[2] * pg8::sigmoidf_(pg8::bf_lo(op.w)); x[7] *= g1[3] * pg8::sigmoidf_(pg8::bf_hi(op.w));
                u32x4_t w; w.x = pg8::cvt_pk_bf16(x[0], x[1]); w.y = pg8::cvt_pk_bf16(x[2], x[3]); w.z = pg8::cvt_pk_bf16(x[4], x[5]); w.w = pg8::cvt_pk_bf16(x[6], x[7]);
                *(u32x4_t*)(YC + grow * YK + vcol) = w;
            }
        }
    }
}
}
__device__ __forceinline__ void cvt_catch_up(const Params& p, int limit, volatile LAS unsigned* st, int nwaves) {
    const int tid = tid_l(); const int wid = tid >> 6, lane = tid & 63;
    unsigned cur = st[8 + wid];
    for (; cur < (unsigned)limit; cur += (unsigned)nwaves) cvt_wave_tile(p, (int)cur, lane);
    st[8 + wid] = cur;
}
__device__ __forceinline__ void convq_catch_up(const Params& p, int layer, volatile LAS unsigned* st, int nwaves) {
    const int tid = tid_l(); const int wid = tid >> 6, lane = tid & 63;
    unsigned dq = st[16 + wid];
    for (; dq < 2048u; dq += (unsigned)nwaves) conv_wave_item(p, layer, (int)dq, lane);
    st[16 + wid] = dq;
}
__device__ __forceinline__ void amerge_catch_up(const Params& p, volatile LAS unsigned* st, int nwaves) {
    const int tid = tid_l(); const int wid = tid >> 6, lane = tid & 63;
    unsigned dm = st[24 + wid];
    for (; dm < (unsigned)AM_TILES; dm += (unsigned)nwaves) amerge_wave_tile(p, (int)dm, lane);
    st[24 + wid] = dm;
}
template <int MODE>
__device__ __forceinline__ void grid_barrier(unsigned char* wsp, volatile LAS unsigned* st, const Params& p, int limit  , int nwaves, int layer = 0) {
    asm volatile("" : "+s"(wsp));
    unsigned* bar = (unsigned*)(wsp + WS_CTRL); const unsigned x = xb_xcc_id();
    asm volatile("s_waitcnt vmcnt(0)" ::: "memory");
    __syncthreads();
    if (threadIdx.x == 0) {
        __builtin_amdgcn_s_waitcnt(0);
        unsigned nloc = st[0], nx = st[1];
        if (nloc == 0u) { xcd_barrier_complete(bar, x, nloc, nx); st[0] = nloc; st[1] = nx; }
        const unsigned old = xb_add(&bar[XB_XSUB(x)], 1u);
        const unsigned gen = old / nloc;
        if (old + 1u == (gen + 1u) * nloc) {
            __builtin_amdgcn_fence(__ATOMIC_RELEASE, "agent");
            asm volatile("s_waitcnt vmcnt(0)" ::: "memory");
            const unsigned og = xb_add(&bar[XB_TOP], 1u);
            const unsigned tg = og / nx;
            if (og + 1u == (tg + 1u) * nx) xb_add(&bar[XB_TOPGEN], 1u);
            else XB_SPIN(xb_ld(&bar[XB_TOPGEN]) == tg, bar);
            __builtin_amdgcn_fence(__ATOMIC_ACQUIRE, "agent");
            xb_add(&bar[XB_XGEN(x)], 1u);
            asm volatile("s_waitcnt vmcnt(0)" ::: "memory");
            st[2] = 0u;
        } else { st[2] = 1u; st[3] = gen; }
    }
    __syncthreads();
    if (st[2] != 0u) {
        const int tid = tid_l(); const int wid = tid >> 6, lane = tid & 63;
        if (wid == 0) {
            if (lane == 0) { const unsigned gen = st[3];
                XB_SPIN(xb_ld(&bar[XB_XGEN(x)]) == gen, bar);
                __builtin_amdgcn_fence(__ATOMIC_ACQUIRE, "agent");
                asm volatile("s_waitcnt vmcnt(0)" ::: "memory");
                st[2] = 2u; }
        } else {
            unsigned cur = st[8 + wid], dq = MODE == 1 ? st[16 + wid] : 0u, dm = MODE == 2 ? st[24 + wid] : 0u;
            while (st[2] != 2u) {
                if (MODE == 1 && dq < 2048u) { conv_wave_item(p, layer, (int)dq, lane); dq += (unsigned)nwaves; }
                else if (MODE == 2 && dm < (unsigned)AM_TILES) { amerge_wave_tile(p, (int)dm, lane); dm += (unsigned)nwaves; }
                else if (cur < (unsigned)limit) { cvt_wave_tile(p, (int)cur, lane); cur += (unsigned)nwaves; }
                else __builtin_amdgcn_s_sleep(8);
            }
            st[8 + wid] = cur; if (MODE == 1) st[16 + wid] = dq; if (MODE == 2) st[24 + wid] = dm;
        }
    }
    __syncthreads();
}
constexpr int RS_UNITS = 16;
constexpr int MEGA_LDS = pg8::STAGE_BYTES + 128 + RS_UNITS * 256 * 4;
template <class Sched>
__device__ __forceinline__ void rs_prefill(const Sched& S, const unsigned long long* stats, PG8_LAS float* rsl) {
    const int tid = tid_l();
    constexpr int NK = RS_UNITS * 256 / 512;
    unsigned long long v[NK]; bool ok[NK];
#pragma unroll
    for (int k = 0; k < NK; ++k) {
        const int j = tid + 512 * k, i = j >> 8; pg8::Unit u; u.pm = 0; u.pn = 0;
        ok[k] = i < RS_UNITS && S.next(i, u);
        v[k] = __hip_atomic_load(stats + (size_t)(ok[k] ? u.pm : 0) * 256 + (j & 255), __ATOMIC_RELAXED, __HIP_MEMORY_SCOPE_AGENT);
    }
#pragma unroll
    for (int k = 0; k < NK; ++k) if (ok[k]) rsl[tid + 512 * k] = rsqrtf((float)v[k] * (1.0f / (pg8::SS_SCALE * 2048.0f)) + 1e-6f);
    __syncthreads();
}
#ifndef WGM_INPROJ
#define WGM_INPROJ 4
#endif
#ifndef WGM_UP
#define WGM_UP 4
#endif
#ifndef WGM_N8
#define WGM_N8 4
#endif
__global__ __launch_bounds__(512, 2) void k_mega(Params p) {
    extern __shared__ __attribute__((aligned(16))) unsigned char shm[];
    const int bid = blockIdx.x, nblk = gridDim.x;
    volatile LAS unsigned* xw = (volatile LAS unsigned*)(shm + pg8::STAGE_BYTES);
    if (threadIdx.x < 8) xw[threadIdx.x] = 0u;
    if (threadIdx.x < 8) xw[8 + threadIdx.x] = (unsigned)(CVT_TPL + bid * 8 + threadIdx.x);
    __syncthreads();
    (void)xcd_barrier_post((unsigned*)(p.ws + WS_CTRL), xw);
    unsigned char* ws = p.ws;
    bf16_t* XN = (bf16_t*)(ws + WS_XN); unsigned long long* ST = (unsigned long long*)(ws + WS_STATS); unsigned long long* STB = ST + MTOK; bf16_t* P = (bf16_t*)(ws + WS_P); float* GT = (float*)(ws + WS_GATES);
    bf16_t* YA = (bf16_t*)(ws + WS_YA);
    bf16_t* MG = (bf16_t*)(ws + WS_MERGED); bf16_t* U = (bf16_t*)(ws + WS_P);
    PG8_LAS unsigned char* glds = (PG8_LAS unsigned char*)shm;
    { const int tid = tid_l(); for (int it = bid * 8 + (tid >> 6); it < CVT_TPL; it += nblk * 8) cvt_wave_tile(p, it, tid & 63); }
    ph_tables(p, bid, nblk);
    ph_xprep(p.x, XN, ST, bid, nblk);
    grid_barrier<0>(p.ws, xw, p, 2 * CVT_TPL, nblk * 8);
#pragma unroll 1
    for (int l = 0; l < DEPTH; ++l) {
        const int lim = (l + 2 < DEPTH ? l + 2 : DEPTH) * CVT_TPL;
        if ((threadIdx.x & 63) == 0) { xw[16 + (threadIdx.x >> 6)] = (unsigned)(bid * 8 + (threadIdx.x >> 6)); xw[24 + (threadIdx.x >> 6)] = (unsigned)(bid * 8 + (threadIdx.x >> 6)); }
        { pg8::Gemm g{XN, (const bf16_t*)(ws + WS_WT_IN + l * SZ_WT_IN), MTOK, LDP, DM, 0}; pg8::EpiInProj E{P, GT, (const PG8_LAS float*)(glds + pg8::STAGE_BYTES + 128), LDP, 27, 51, 0};
          pg8::StaticOrder S; S.init(g.M, g.N, nblk, bid, WGM_INPROJ); rs_prefill(S, ST, (PG8_LAS float*)(glds + pg8::STAGE_BYTES + 128)); pg8::gemm_phase<pg8::EpiInProj, pg8::StaticOrder, true, true, true, true>(glds, g, S, E); }
        grid_barrier<0>(p.ws, xw, p, lim, nblk * 8);
        ph_thin(p, l, bid, nblk, (char*)shm);
        ph_gatescan(p, l, bid, nblk, (char*)shm);
        grid_barrier<1>(p.ws, xw, p, lim, nblk * 8, l);
        ph_attn_b(p, l, bid, nblk, (char*)shm);
        ph_attn_a(p, l, bid, nblk, (char*)shm);
        ml::ph_ml_state(p, bid, nblk);
        grid_barrier<1>(p.ws, xw, p, lim, nblk * 8, l);
        ml::ph_ml_scan(p, bid, nblk);
        convq_catch_up(p, l, xw, nblk * 8);
        grid_barrier<2>(p.ws, xw, p, lim, nblk * 8, l);
        ml::ph_ml_out(p, l, bid, nblk, (char*)shm);
        amerge_catch_up(p, xw, nblk * 8);
        grid_barrier<0>(p.ws, xw, p, lim, nblk * 8);
        { pg8::Gemm g{YA, (const bf16_t*)(ws + WS_WT_A + l * SZ_WT_CAT), MTOK, DM, YK, 0}; pg8::EpiBranchCat E{P + COL_G, MG, LDP, DM};
          pg8::StaticOrder S; S.init(g.M, g.N, nblk, bid, WGM_N8); pg8::gemm_phase<pg8::EpiBranchCat, pg8::StaticOrder, true, true, false>(glds, g, S, E); }
        grid_barrier<0>(p.ws, xw, p, lim, nblk * 8);
        { pg8::Gemm g{MG, (const bf16_t*)(ws + WS_WT_OUT + l * SZ_WT_OUT), MTOK, DM, DM, 0}; pg8::EpiResid E{XN, p.out, STB, DM, 0};
          pg8::StaticOrder S; S.init(g.M, g.N, nblk, bid, WGM_N8); pg8::gemm_phase<pg8::EpiResid, pg8::StaticOrder, true, true, false>(glds, g, S, E); }
        grid_barrier<0>(p.ws, xw, p, lim, nblk * 8);
        { pg8::Gemm g{XN, (const bf16_t*)(ws + WS_WT_UP + l * SZ_WT_UP), MTOK, DFF, DM, 0}; pg8::EpiRelu2 E{U, (const PG8_LAS float*)(glds + pg8::STAGE_BYTES + 128), DFF, 0};
          pg8::StaticOrder S; S.init(g.M, g.N, nblk, bid, WGM_UP); rs_prefill(S, STB, (PG8_LAS float*)(glds + pg8::STAGE_BYTES + 128)); pg8::gemm_phase<pg8::EpiRelu2, pg8::StaticOrder, true, true, true, true>(glds, g, S, E); }
        grid_barrier<0>(p.ws, xw, p, lim, nblk * 8);
        { pg8::Gemm g{U, (const bf16_t*)(ws + WS_WT_DOWN + l * SZ_WT_UP), MTOK, DM, DFF, 0}; pg8::EpiResid E{XN, p.out, ST, DM, l == DEPTH - 1 ? 1 : 0};
          pg8::StaticOrder S; S.init(g.M, g.N, nblk, bid, WGM_N8); pg8::gemm_phase<pg8::EpiResid, pg8::StaticOrder, true, true, true>(glds, g, S, E); }
        if (l + 1 < DEPTH) {
            cvt_catch_up(p, lim, xw, nblk * 8);
            grid_barrier<0>(p.ws, xw, p, lim, nblk * 8);
        }
    }
}

extern "C" void kernel_launch(void* const* d_in, const int* in_sizes, int n_in, void* d_out, int out_size, void* d_ws, size_t ws_size, hipStream_t stream) {
    if (n_in != 18 || out_size != MTOK * DM || ws_size < WS_END) { fprintf(stderr, "kernel_launch: bad shapes n_in %d out %d ws %zu (need %zu)\n", n_in, out_size, ws_size, (size_t)WS_END); return; }
    Params p{};
    p.x = (const float*)d_in[0]; p.norm1_g = (const float*)d_in[1]; p.w_in = (const float*)d_in[2]; p.a_q_gain = (const float*)d_in[3]; p.a_k_gain = (const float*)d_in[4];
    p.b_q_gain = (const float*)d_in[5]; p.b_k_gain = (const float*)d_in[6]; p.c_conv_w = (const float*)d_in[7]; p.c_conv_b = (const float*)d_in[8]; p.c_gate_b = (const float*)d_in[9];
    p.c_out_g = (const float*)d_in[10]; p.w_a = (const float*)d_in[11]; p.w_b = (const float*)d_in[12]; p.w_c = (const float*)d_in[13]; p.w_out = (const float*)d_in[14];
    p.norm2_g = (const float*)d_in[15]; p.w_up = (const float*)d_in[16]; p.w_down = (const float*)d_in[17]; p.out = (float*)d_out; p.ws = (unsigned char*)d_ws;
    static int grid = 0;
    if (!grid) {
        int dev = 0, cus = 0, per_cu = 0;
        (void)hipGetDevice(&dev); (void)hipDeviceGetAttribute(&cus, hipDeviceAttributeMultiprocessorCount, dev);
        (void)hipFuncSetAttribute((const void*)k_mega, hipFuncAttributeMaxDynamicSharedMemorySize, MEGA_LDS);
        (void)hipOccupancyMaxActiveBlocksPerMultiprocessor(&per_cu, k_mega, 512, MEGA_LDS);
        if (per_cu < 1 || cus < 1) { fprintf(stderr, "kernel_launch: occupancy query says %d blocks/CU on %d CUs\n", per_cu, cus); return; }
        grid = cus;
        if ((MTOK / 256) * (LDP / 256) > RS_UNITS * cus) { fprintf(stderr, "kernel_launch: %d CUs are too few for the rstd table (%d units per workgroup)\n", cus, RS_UNITS); grid = 0; return; }
    }
    (void)hipMemsetAsync(d_ws, 0, XCD_BAR_WORDS * sizeof(unsigned), stream);
    hipLaunchKernelGGL(k_mega, dim3(grid), dim3(512), MEGA_LDS, stream, p);
    const hipError_t le = hipPeekAtLastError();
    if (le != hipSuccess) fprintf(stderr, "kernel_launch: launch failed: %s\n", hipGetErrorName(le));
}
```

```cpp
#include <hip/hip_runtime.h>
#include <cstdio>
#include <cstdint>

__device__ __forceinline__ int tid_l() { int t = (int)threadIdx.x; asm volatile("" : "+v"(t)); return t; }
namespace pg8 {
#define PG8_LAS __attribute__((address_space(3)))
typedef unsigned short bf16_t;
typedef short bf16x8 __attribute__((ext_vector_type(8)));
typedef float f32x4 __attribute__((ext_vector_type(4)));
typedef unsigned u32x4 __attribute__((ext_vector_type(4)));
constexpr int BM = 256, BK = 64, HALF = 128, HTB = HALF * BK * 2  , STAGE_BYTES = 8 * HTB, NXCD = 8, WGM = 4;

__host__ __device__ __forceinline__ int lds_byte(int r, int c) { const int st = (r >> 4) * 2 + (c >> 5), rr = r & 15, cc = c & 31, ob = rr * 64 + cc * 2; return st * 1024 + (ob ^ (((ob >> 9) & 1) << 5)); }
__host__ __device__ __forceinline__ void stage_rc(int b, int& R, int& C) { const int st = b / 1024, sb = b % 1024, swz = sb ^ (((sb >> 9) & 1) << 5); R = (st >> 1) * 16 + swz / 64; C = (st & 1) * 32 + (swz % 64) / 2; }
__host__ __device__ __forceinline__ int perm32(int rho) { const int n = rho >> 4, i = rho & 15; return 8 * (i >> 2) + 4 * n + (i & 3); }

struct Unit { int pm, pn; };
struct Gemm { const bf16_t* A; const bf16_t* Bt; int M, N, K, pad_; };

struct StaticOrder {
    int nM, nN, nwg, G, c, wgm;
    __host__ __device__ void init(int M, int N, int G_, int c_, int wgm_ = WGM) { nM = M / BM; nN = N / BM; nwg = nM * nN; G = G_; c = c_; wgm = wgm_; }
    __host__ __device__ bool next(int i, Unit& u) const {
        const long L = (long)i * G + c; if (L >= nwg) return false;
        int wgid = (int)L; { const int q = nwg / NXCD, r = nwg % NXCD, xcd = wgid % NXCD, off = wgid / NXCD; wgid = (xcd < r ? xcd * (q + 1) : r * (q + 1) + (xcd - r) * q) + off; }
        const int nig = wgm * nN, gid = wgid / nig, fm = gid * wgm, gsz = (nM - fm) < wgm ? (nM - fm) : wgm;
        u.pm = fm + ((wgid % nig) % gsz); u.pn = (wgid % nig) / gsz; return true;
    }
    __device__ __forceinline__ void a_ready(const Unit&) const {}
    __device__ __forceinline__ void done(const Unit&) const {}
};
__device__ __forceinline__ unsigned cvt_pk_bf16(float lo, float hi) { unsigned r; asm volatile("v_cvt_pk_bf16_f32 %0, %1, %2" : "=v"(r) : "v"(lo), "v"(hi)); return r; }
typedef _Float16 f16x2_t __attribute__((ext_vector_type(2)));
typedef _Float16 f16x8_t __attribute__((ext_vector_type(8)));
__device__ __forceinline__ unsigned cvt_pk_f16(float lo, float hi) { const f16x2_t h = {(_Float16)lo, (_Float16)hi}; return __builtin_bit_cast(unsigned, h); }
__device__ __forceinline__ float f16_lo(unsigned w) { return (float)__builtin_bit_cast(f16x2_t, w)[0]; }
__device__ __forceinline__ float f16_hi(unsigned w) { return (float)__builtin_bit_cast(f16x2_t, w)[1]; }
template <bool F16> __device__ __forceinline__ f32x4 mma16(const bf16x8 b, const bf16x8 a, const f32x4 c) {
    if constexpr (F16) return __builtin_amdgcn_mfma_f32_16x16x32_f16(__builtin_bit_cast(f16x8_t, b), __builtin_bit_cast(f16x8_t, a), c, 0, 0, 0);
    else return __builtin_amdgcn_mfma_f32_16x16x32_bf16(b, a, c, 0, 0, 0);
}
__device__ __forceinline__ float sigmoidf_(float x) { return __builtin_amdgcn_rcpf(1.0f + __builtin_amdgcn_exp2f(x * -1.4426950408889634f)); }
__device__ __forceinline__ float bf_lo(unsigned w) { return __uint_as_float(w << 16); }
__device__ __forceinline__ float bf_hi(unsigned w) { return __uint_as_float(w & 0xffff0000u); }

constexpr float SS_SCALE = 1048576.0f;
__device__ __forceinline__ float row_rstd1(const unsigned long long* ss, size_t row) {
    const unsigned long long v = __hip_atomic_load(ss + row, __ATOMIC_RELAXED, __HIP_MEMORY_SCOPE_AGENT);
    return rsqrtf((float)v * (1.0f / (SS_SCALE * 2048.0f)) + 1e-6f);
}
struct EpiInProj {
    static constexpr bool PERM = true, AFTER_DRAIN = false, USE_UI = true; static constexpr int NSEG = 1;
    bf16_t* O; float* gates; const PG8_LAS float* rsl; int ldc, t_sig0, t_gate, pad_;
    __device__ __forceinline__ void operator()(const f32x4 (&acc)[2][2][4][2], const Unit& u, int ui, int wr, int wc, int fr, int fq) const {
        const int row0 = u.pm * BM + wr * 64 + fr; const int col0 = u.pn * BM + wc * 32 + 8 * fq;
        float rsv[2][4];
#pragma unroll
        for (int ai = 0; ai < 2; ++ai)
#pragma unroll
            for (int m = 0; m < 4; ++m) rsv[ai][m] = rsl[ui * BM + wr * 64 + fr + ai * HALF + m * 16];
        if (u.pn == t_gate) {
            if (wc == 0) {
#pragma unroll
                for (int ai = 0; ai < 2; ++ai)
#pragma unroll
                    for (int m = 0; m < 4; ++m) { float* gp = gates + (size_t)(row0 + ai * HALF + m * 16) * 32 + 8 * fq; const float rs = rsv[ai][m];
                        *(f32x4*)(gp) = acc[ai][0][m][0] * rs; *(f32x4*)(gp + 4) = acc[ai][0][m][1] * rs; }
            }
            return;
        }
        const bool sig = u.pn >= t_sig0;
#pragma unroll
        for (int ai = 0; ai < 2; ++ai)
#pragma unroll
            for (int m = 0; m < 4; ++m) { bf16_t* rowp = O + (size_t)(row0 + ai * HALF + m * 16) * ldc + col0; const float rs = rsv[ai][m];
#pragma unroll
                for (int bj = 0; bj < 2; ++bj) { f32x4 v0 = acc[ai][bj][m][0] * rs, v1 = acc[ai][bj][m][1] * rs;
                    if (sig) {
#pragma unroll
                        for (int j = 0; j < 4; ++j) { v0[j] = sigmoidf_(v0[j]); v1[j] = sigmoidf_(v1[j]); } }
                    u32x4 w; w.x = cvt_pk_bf16(v0[0], v0[1]); w.y = cvt_pk_bf16(v0[2], v0[3]); w.z = cvt_pk_bf16(v1[0], v1[1]); w.w = cvt_pk_bf16(v1[2], v1[3]);
                    __builtin_nontemporal_store(w, (u32x4*)(rowp + bj * HALF)); } }
    }
};

struct EpiBranchCat {
    static constexpr bool PERM = true, AFTER_DRAIN = false, USE_UI = false;
    static constexpr int NSEG = 3, SEG1 = 768 / BK, SEG2 = (768 + 1024) / BK;
    const bf16_t* G; bf16_t* out; int ldg, ldc;
    __device__ __forceinline__ void boundary(f32x4 (&acc)[2][2][4][2], const Unit& u, int seg  , int wr, int wc, int fr, int fq) const {
        int row0 = u.pm * BM + wr * 64 + fr; int col0 = u.pn * BM + wc * 32 + 8 * fq;
        asm volatile("" : "+v"(row0), "+v"(col0));
#pragma unroll
        for (int ai = 0; ai < 2; ++ai) {
            u32x4 gp[4][2], gn[4][2];
#pragma unroll
            for (int m = 0; m < 4; ++m) { const size_t r = (size_t)(row0 + ai * HALF + m * 16);
#pragma unroll
                for (int bj = 0; bj < 2; ++bj) { const int c = col0 + bj * HALF;
                    gp[m][bj] = *(const u32x4*)(G + r * ldg + (size_t)(seg - 1) * ldc + c); gn[m][bj] = *(const u32x4*)(G + r * ldg + (size_t)seg * ldc + c); } }
#pragma unroll
            for (int m = 0; m < 4; ++m)
#pragma unroll
                for (int bj = 0; bj < 2; ++bj) { const u32x4 p_ = gp[m][bj], n_ = gn[m][bj];
                    f32x4 r0, r1;
                    r0[0] = fmaxf(bf_lo(p_.x), 1e-30f) * __builtin_amdgcn_rcpf(fmaxf(bf_lo(n_.x), 1e-30f)); r0[1] = fmaxf(bf_hi(p_.x), 1e-30f) * __builtin_amdgcn_rcpf(fmaxf(bf_hi(n_.x), 1e-30f));
                    r0[2] = fmaxf(bf_lo(p_.y), 1e-30f) * __builtin_amdgcn_rcpf(fmaxf(bf_lo(n_.y), 1e-30f)); r0[3] = fmaxf(bf_hi(p_.y), 1e-30f) * __builtin_amdgcn_rcpf(fmaxf(bf_hi(n_.y), 1e-30f));
                    r1[0] = fmaxf(bf_lo(p_.z), 1e-30f) * __builtin_amdgcn_rcpf(fmaxf(bf_lo(n_.z), 1e-30f)); r1[1] = fmaxf(bf_hi(p_.z), 1e-30f) * __builtin_amdgcn_rcpf(fmaxf(bf_hi(n_.z), 1e-30f));
                    r1[2] = fmaxf(bf_lo(p_.w), 1e-30f) * __builtin_amdgcn_rcpf(fmaxf(bf_lo(n_.w), 1e-30f)); r1[3] = fmaxf(bf_hi(p_.w), 1e-30f) * __builtin_amdgcn_rcpf(fmaxf(bf_hi(n_.w), 1e-30f));
                    acc[ai][bj][m][0] *= r0; acc[ai][bj][m][1] *= r1; }
            asm volatile("" ::: "memory"); }
    }
    __device__ __forceinline__ void operator()(const f32x4 (&acc)[2][2][4][2], const Unit& u, int wr, int wc, int fr, int fq) const {
        const int row0 = u.pm * BM + wr * 64 + fr; const int col0 = u.pn * BM + wc * 32 + 8 * fq;
        u32x4 gall[2][4][2];
#pragma unroll
        for (int ai = 0; ai < 2; ++ai)
#pragma unroll
            for (int m = 0; m < 4; ++m)
#pragma unroll
                for (int bj = 0; bj < 2; ++bj) gall[ai][m][bj] = *(const u32x4*)(G + (size_t)(row0 + ai * HALF + m * 16) * ldg + (size_t)2 * ldc + col0 + bj * HALF);
#pragma unroll
        for (int ai = 0; ai < 2; ++ai)
#pragma unroll
            for (int m = 0; m < 4; ++m) { const size_t r = (size_t)(row0 + ai * HALF + m * 16);
#pragma unroll
                for (int bj = 0; bj < 2; ++bj) { const int c = col0 + bj * HALF;
                    const u32x4 gw = gall[ai][m][bj];
                    f32x4 v0 = acc[ai][bj][m][0], v1 = acc[ai][bj][m][1];
                    v0[0] *= fmaxf(bf_lo(gw.x), 1e-30f); v0[1] *= fmaxf(bf_hi(gw.x), 1e-30f); v0[2] *= fmaxf(bf_lo(gw.y), 1e-30f); v0[3] *= fmaxf(bf_hi(gw.y), 1e-30f);
                    v1[0] *= fmaxf(bf_lo(gw.z), 1e-30f); v1[1] *= fmaxf(bf_hi(gw.z), 1e-30f); v1[2] *= fmaxf(bf_lo(gw.w), 1e-30f); v1[3] *= fmaxf(bf_hi(gw.w), 1e-30f);
                    u32x4 w; w.x = cvt_pk_bf16(v0[0], v0[1]); w.y = cvt_pk_bf16(v0[2], v0[3]); w.z = cvt_pk_bf16(v1[0], v1[1]); w.w = cvt_pk_bf16(v1[2], v1[3]);
                    *(u32x4*)(out + r * ldc + c) = w; } }
    }
};

struct EpiResid {
    static constexpr bool PERM = true, AFTER_DRAIN = false, USE_UI = false; static constexpr int NSEG = 1;
    bf16_t* xh; float* out; unsigned long long* stats; int ldc, fin;
    __device__ __forceinline__ void operator()(const f32x4 (&acc)[2][2][4][2], const Unit& u, int wr, int wc, int fr, int fq) const {
        const int row0 = u.pm * BM + wr * 64 + fr, col0 = u.pn * BM + wc * 32 + 8 * fq;
        bf16_t* const hp0 = xh + ((size_t)u.pm * (ldc / 64) + u.pn * 4 + (wc >> 1)) * 16384 + (wr * 64 + fr) * 64 + (wc & 1) * 32 + 8 * fq;
        u32x4 bq[2][2][2];
#pragma unroll
        for (int mm = 0; mm < 2; ++mm)
#pragma unroll
            for (int bj = 0; bj < 2; ++bj) bq[0][mm][bj] = *(const u32x4*)(hp0 + bj * 2 * 16384 + (mm * 16) * 64);
#pragma unroll
        for (int q = 0; q < 4; ++q) { const int ai = q >> 1, mb = (q & 1) * 2;
            if (q < 3) { const int ai2 = (q + 1) >> 1, mb2 = ((q + 1) & 1) * 2;
#pragma unroll
                for (int mm = 0; mm < 2; ++mm)
#pragma unroll
                    for (int bj = 0; bj < 2; ++bj) bq[(q + 1) & 1][mm][bj] = *(const u32x4*)(hp0 + bj * 2 * 16384 + (ai2 * HALF + (mb2 + mm) * 16) * 64); }
#pragma unroll
            for (int mm = 0; mm < 2; ++mm) { const int m = mb + mm; const size_t row = (size_t)(row0 + ai * HALF + m * 16); float s = 0.f;
#pragma unroll
                for (int bj = 0; bj < 2; ++bj) {
                    bf16_t* hp = hp0 + bj * 2 * 16384 + (ai * HALF + m * 16) * 64;
                    const u32x4 bw = bq[q & 1][mm][bj];
                    f32x4 v0 = acc[ai][bj][m][0], v1 = acc[ai][bj][m][1];
                    v0[0] += f16_lo(bw.x); v0[1] += f16_hi(bw.x); v0[2] += f16_lo(bw.y); v0[3] += f16_hi(bw.y); v1[0] += f16_lo(bw.z); v1[1] += f16_hi(bw.z); v1[2] += f16_lo(bw.w); v1[3] += f16_hi(bw.w);
                    if (fin) { float* op = out + row * ldc + col0 + bj * HALF; *(f32x4*)op = v0; *(f32x4*)(op + 4) = v1; }
                    else { u32x4 w; w.x = cvt_pk_f16(v0[0], v0[1]); w.y = cvt_pk_f16(v0[2], v0[3]); w.z = cvt_pk_f16(v1[0], v1[1]); w.w = cvt_pk_f16(v1[2], v1[3]);
                        *(u32x4*)hp = w;
                        s += (v0[0] * v0[0] + v0[1] * v0[1]) + (v0[2] * v0[2] + v0[3] * v0[3]) + (v1[0] * v1[0] + v1[1] * v1[1]) + (v1[2] * v1[2] + v1[3] * v1[3]); } }
                if (!fin) { s += __shfl_xor(s, 16); s += __shfl_xor(s, 32);
                    if (fq == 0) (void)__hip_atomic_fetch_add(stats + row, (unsigned long long)(s * SS_SCALE + 0.5f), __ATOMIC_RELAXED, __HIP_MEMORY_SCOPE_AGENT); } } }
    }
};

struct EpiRelu2 {
    static constexpr bool PERM = true, AFTER_DRAIN = false, USE_UI = true; static constexpr int NSEG = 1;
    bf16_t* O; const PG8_LAS float* rsl; int ldc, pad_;
    __device__ __forceinline__ void operator()(const f32x4 (&acc)[2][2][4][2], const Unit& u, int ui, int wr, int wc, int fr, int fq) const {
        const int row0 = u.pm * BM + wr * 64 + fr; const int col0 = u.pn * BM + wc * 32 + 8 * fq;
        float rsv[2][4];
#pragma unroll
        for (int ai = 0; ai < 2; ++ai)
#pragma unroll
            for (int m = 0; m < 4; ++m) rsv[ai][m] = rsl[ui * BM + wr * 64 + fr + ai * HALF + m * 16];
#pragma unroll
        for (int ai = 0; ai < 2; ++ai)
#pragma unroll
            for (int m = 0; m < 4; ++m) { bf16_t* rowp = O + ((size_t)u.pm * (ldc / 64) + u.pn * 4 + (wc >> 1)) * 16384 + (wr * 64 + fr + ai * HALF + m * 16) * 64 + (wc & 1) * 32 + 8 * fq;
                const float rs = rsv[ai][m];
#pragma unroll
                for (int bj = 0; bj < 2; ++bj) { f32x4 v0 = acc[ai][bj][m][0] * rs, v1 = acc[ai][bj][m][1] * rs;
#pragma unroll
                    for (int j = 0; j < 4; ++j) { const float a = fmaxf(v0[j], 0.f), b = fmaxf(v1[j], 0.f); v0[j] = a * a; v1[j] = b * b; }
                    u32x4 w; w.x = cvt_pk_bf16(v0[0], v0[1]); w.y = cvt_pk_bf16(v0[2], v0[3]); w.z = cvt_pk_bf16(v1[0], v1[1]); w.w = cvt_pk_bf16(v1[2], v1[3]);
                    __builtin_nontemporal_store(w, (u32x4*)(rowp + bj * 2 * 16384)); } }
    }
};
template <class Epi, class Sched, bool ALIGN_EPI = false, bool SP2 = false, bool PANEL = false, bool F16 = false>
__device__ __forceinline__ void gemm_phase(PG8_LAS unsigned char* lds, const Gemm g, const Sched& S, const Epi& E) {
    const int tid = tid_l(), wid = __builtin_amdgcn_readfirstlane(tid >> 6), lane = tid & 63, wr = wid >> 2, wc = wid & 3, fr = lane & 15, fq = lane >> 4;
    const int K = g.K, nt = K / BK;
    unsigned voffA[2], voffB[2];
#pragma unroll
    for (int i = 0; i < 2; ++i) { int R, C; stage_rc(tid * 16 + i * 8192, R, C); const int Rb = Epi::PERM ? ((R & ~31) + perm32(R & 31)) : R;
        voffA[i] = PANEL ? (unsigned)(R * BK + C) * 2u : (unsigned)(R * K + C) * 2u; voffB[i] = PANEL ? (unsigned)(Rb * BK + C) * 2u : (unsigned)(Rb * K + C) * 2u; }
    const size_t kstep = PANEL ? (size_t)(BM * BK * 2) : (size_t)(BK * 2);
    const size_t hstep = PANEL ? (size_t)(HALF * BK * 2) : (size_t)HALF * K * 2;
    const size_t tstep = PANEL ? (size_t)nt * (BM * BK * 2) : 2 * hstep;
    const unsigned ldsw = (unsigned)wid * 1024u;
    const int aoff = lds_byte(wr * 64 + fr, fq * 8), boff = lds_byte(wc * 32 + fr, fq * 8);
#define PG8_SA(b, h) (((b) * 2 + (h)) * HTB)
#define PG8_SB(b, h) ((4 + (b) * 2 + (h)) * HTB)
#define PG8_STAGE(bufoff, gbase, voff) do { _Pragma("unroll") for (int _i = 0; _i < 2; ++_i) \
        __builtin_amdgcn_global_load_lds((const unsigned*)((const char*)(gbase) + (voff)[_i]), (PG8_LAS unsigned*)(lds + (bufoff) + ldsw + _i * 8192), 16, 0, 0); } while (0)
#define PG8_LDA(dst, b, h) do { _Pragma("unroll") for (int m = 0; m < 4; ++m) _Pragma("unroll") for (int k = 0; k < 2; ++k) dst[m][k] = *(const PG8_LAS bf16x8*)(lds + PG8_SA(b, h) + aoff + m * 2048 + k * 1024); } while (0)
#define PG8_LDB(dst, b, h) do { _Pragma("unroll") for (int n = 0; n < 2; ++n) _Pragma("unroll") for (int k = 0; k < 2; ++k) dst[n][k] = *(const PG8_LAS bf16x8*)(lds + PG8_SB(b, h) + boff + n * 2048 + k * 1024); } while (0)
#define PG8_MMA(ai, bj, At, Bt) do { __builtin_amdgcn_s_setprio(1); _Pragma("unroll") for (int m = 0; m < 4; ++m) _Pragma("unroll") for (int n = 0; n < 2; ++n) _Pragma("unroll") for (int k = 0; k < 2; ++k) \
        acc[ai][bj][m][n] = mma16<F16>(Bt[n][k], At[m][k], acc[ai][bj][m][n]); __builtin_amdgcn_s_setprio(0); } while (0)
#define PG8_WAIT_V(n) asm volatile("s_waitcnt vmcnt(" #n ")" ::: "memory")
#define PG8_WAIT_L(n) asm volatile("s_waitcnt lgkmcnt(" #n ")" ::: "memory")
#define PG8_BAR __builtin_amdgcn_s_barrier()
#define PG8_SCHED __builtin_amdgcn_sched_barrier(0)
    Unit cur, nxt; int ui = 0;
    if (!S.next(0, cur)) return;
    f32x4 acc[2][2][4][2];
#pragma unroll
    for (int a = 0; a < 2; ++a)
#pragma unroll
        for (int b = 0; b < 2; ++b)
#pragma unroll
            for (int m = 0; m < 4; ++m)
#pragma unroll
                for (int n = 0; n < 2; ++n) acc[a][b][m][n] = (f32x4){0.f, 0.f, 0.f, 0.f};
    bf16x8 At[4][2], B0[2][2], B1[2][2];
    const char* cA = (const char*)g.A + (size_t)cur.pm * tstep; const char* cB = (const char*)g.Bt + (size_t)cur.pn * tstep;
    S.a_ready(cur);
    if constexpr (SP2) {
        PG8_STAGE(PG8_SB(0, 0), cB, voffB); PG8_STAGE(PG8_SB(0, 1), cB + hstep, voffB); PG8_STAGE(PG8_SA(0, 0), cA, voffA); PG8_STAGE(PG8_SA(0, 1), cA + hstep, voffA);
        if (wr == 1) PG8_BAR;
        PG8_WAIT_V(2); PG8_BAR;
        PG8_STAGE(PG8_SB(1, 0), cB + kstep, voffB); PG8_STAGE(PG8_SA(1, 0), cA + kstep, voffA); PG8_STAGE(PG8_SB(1, 1), cB + hstep + kstep, voffB);
        PG8_WAIT_V(6); PG8_BAR;
    } else {
        PG8_STAGE(PG8_SB(0, 0), cB, voffB); PG8_STAGE(PG8_SA(0, 0), cA, voffA); PG8_STAGE(PG8_SB(0, 1), cB + hstep, voffB); PG8_STAGE(PG8_SA(0, 1), cA + hstep, voffA);
        if (wr == 1) PG8_BAR;
        PG8_WAIT_V(4); PG8_BAR;
        PG8_STAGE(PG8_SB(1, 0), cB + kstep, voffB); PG8_STAGE(PG8_SA(1, 0), cA + kstep, voffA); PG8_STAGE(PG8_SB(1, 1), cB + hstep + kstep, voffB);
        PG8_WAIT_V(6); PG8_BAR;
    }
    for (;;) {
        const bool has_next = S.next(ui + 1, nxt);
        const char* nA = has_next ? (const char*)g.A + (size_t)nxt.pm * tstep : cA; const char* nB = has_next ? (const char*)g.Bt + (size_t)nxt.pn * tstep : cB;
        for (int t = 0; t < nt; t += 2) {
            const bool last = (t == nt - 2);
            const char* a1 = cA + (size_t)(t + 1) * kstep;
            const char* a2 = last ? nA : cA + (size_t)(t + 2) * kstep; const char* b2 = last ? nB : cB + (size_t)(t + 2) * kstep;
            const char* a3 = a2 + kstep; const char* b3 = b2 + kstep;
            if (last && has_next) S.a_ready(nxt);
            if constexpr (Epi::NSEG > 1) { if (t == Epi::SEG1 || t == Epi::SEG2) E.boundary(acc, cur, t == Epi::SEG1 ? 1 : 2, wr, wc, fr, fq); }
            if constexpr (SP2) {
            PG8_LDB(B0, 0, 0); PG8_LDB(B1, 0, 1); PG8_SCHED; PG8_LDA(At, 0, 0); PG8_STAGE(PG8_SA(1, 1), a1 + hstep, voffA);
            PG8_WAIT_V(8); PG8_WAIT_L(0); PG8_BAR; PG8_MMA(0, 0, At, B0); PG8_MMA(0, 1, At, B1); PG8_BAR; PG8_SCHED;
            PG8_LDA(At, 0, 1); PG8_STAGE(PG8_SB(0, 0), b2, voffB); PG8_STAGE(PG8_SB(0, 1), b2 + hstep, voffB); PG8_STAGE(PG8_SA(0, 0), a2, voffA);
            PG8_WAIT_V(8); PG8_WAIT_L(0); PG8_BAR; PG8_MMA(1, 0, At, B0); PG8_MMA(1, 1, At, B1); PG8_BAR; PG8_SCHED;
            PG8_LDB(B0, 1, 0); PG8_LDB(B1, 1, 1); PG8_SCHED; PG8_LDA(At, 1, 0); PG8_STAGE(PG8_SA(0, 1), a2 + hstep, voffA);
            PG8_WAIT_V(8); PG8_WAIT_L(0); PG8_BAR; PG8_MMA(0, 0, At, B0); PG8_MMA(0, 1, At, B1); PG8_BAR; PG8_SCHED;
            PG8_LDA(At, 1, 1); PG8_STAGE(PG8_SB(1, 0), b3, voffB); PG8_STAGE(PG8_SB(1, 1), b3 + hstep, voffB); PG8_STAGE(PG8_SA(1, 0), a3, voffA);
            PG8_WAIT_V(8); PG8_WAIT_L(0); PG8_BAR; PG8_MMA(1, 0, At, B0); PG8_MMA(1, 1, At, B1); PG8_BAR; PG8_SCHED;
            } else {
            PG8_LDB(B0, 0, 0); PG8_SCHED; PG8_LDA(At, 0, 0); PG8_STAGE(PG8_SA(1, 1), a1 + hstep, voffA);
            PG8_WAIT_L(8); PG8_BAR; PG8_WAIT_L(0); PG8_MMA(0, 0, At, B0); PG8_BAR; PG8_SCHED;
            PG8_LDB(B1, 0, 1); PG8_STAGE(PG8_SB(0, 0), b2, voffB);
            PG8_BAR; PG8_WAIT_L(0); PG8_MMA(0, 1, At, B1); PG8_BAR;
            PG8_LDA(At, 0, 1); PG8_STAGE(PG8_SA(0, 0), a2, voffA);
            PG8_BAR; PG8_WAIT_L(0); PG8_MMA(1, 0, At, B0); PG8_BAR; PG8_SCHED;
            PG8_STAGE(PG8_SB(0, 1), b2 + hstep, voffB);
            PG8_WAIT_V(6); PG8_BAR; PG8_MMA(1, 1, At, B1); PG8_BAR;
            PG8_LDB(B0, 1, 0); PG8_SCHED; PG8_LDA(At, 1, 0); PG8_STAGE(PG8_SA(0, 1), a2 + hstep, voffA);
            PG8_WAIT_L(8); PG8_BAR; PG8_WAIT_L(0); PG8_MMA(0, 0, At, B0); PG8_BAR; PG8_SCHED;
            PG8_LDB(B1, 1, 1); PG8_STAGE(PG8_SB(1, 0), b3, voffB);
            PG8_BAR; PG8_WAIT_L(0); PG8_MMA(0, 1, At, B1); PG8_BAR;
            PG8_LDA(At, 1, 1); PG8_STAGE(PG8_SA(1, 0), a3, voffA);
            PG8_BAR; PG8_WAIT_L(0); PG8_MMA(1, 0, At, B0); PG8_BAR; PG8_SCHED;
            PG8_STAGE(PG8_SB(1, 1), b3 + hstep, voffB);
            PG8_WAIT_V(6); PG8_BAR; PG8_MMA(1, 1, At, B1); PG8_BAR;
            }
        }
        if constexpr (ALIGN_EPI) { if (wr == 0) PG8_BAR; }
        if constexpr (!Epi::AFTER_DRAIN) { if constexpr (Epi::USE_UI) E(acc, cur, ui, wr, wc, fr, fq); else E(acc, cur, wr, wc, fr, fq); S.done(cur); }
        if (!has_next) break;
#pragma unroll
        for (int a = 0; a < 2; ++a)
#pragma unroll
            for (int b = 0; b < 2; ++b)
#pragma unroll
                for (int m = 0; m < 4; ++m)
#pragma unroll
                    for (int n = 0; n < 2; ++n) acc[a][b][m][n] = (f32x4){0.f, 0.f, 0.f, 0.f};
        cur = nxt; cA = nA; cB = nB; ++ui;
        if constexpr (ALIGN_EPI) { if (wr == 1) PG8_BAR; }
    }
    PG8_WAIT_V(0);
    if constexpr (!ALIGN_EPI) { if (wr == 0) PG8_BAR; }
    PG8_BAR;
    if constexpr (Epi::AFTER_DRAIN) { E.fused(acc, cur, wr, wc, fr, fq, lds, wid, lane); S.done(cur); }
#undef PG8_SA
#undef PG8_SB
#undef PG8_STAGE
#undef PG8_LDA
#undef PG8_LDB
#undef PG8_MMA
#undef PG8_WAIT_V
#undef PG8_WAIT_L
#undef PG8_BAR
#undef PG8_SCHED
}
}

#define XB_TMO      128
#define XB_XCNT(j)  (256  + 64 * (j))
#define XB_XSUB(j)  (1280 + 64 * (j))
#define XB_XGEN(j)  (2304 + 64 * (j))
#define XB_TOP      3328
#define XB_TOPGEN   3392
#define XCD_BAR_WORDS 3456
#define XB_SPIN_CAP (1u << 18)
#define LAS __attribute__((address_space(3)))

__device__ __forceinline__ unsigned xb_ld(unsigned* p)              { return __hip_atomic_load(p, __ATOMIC_RELAXED, __HIP_MEMORY_SCOPE_AGENT); }
__device__ __forceinline__ unsigned xb_add(unsigned* p, unsigned v) { return __hip_atomic_fetch_add(p, v, __ATOMIC_RELAXED, __HIP_MEMORY_SCOPE_AGENT); }
__device__ __forceinline__ unsigned xb_xcc_id() { return (unsigned)__builtin_amdgcn_s_getreg((3 << 11) | 20) & 0xFu; }
#define XB_SPIN(cond, bar) do { unsigned _sp = 0; while (cond) { __builtin_amdgcn_s_sleep(1); \
    if ((++_sp & 255u) == 0u) { if (xb_ld(&(bar)[XB_TMO])) break; if (_sp > XB_SPIN_CAP) { atomicAdd(&(bar)[XB_TMO], 1u); break; } } } } while (0)

struct XcdBarrier {
    unsigned* bar; unsigned x;
    volatile LAS unsigned* st;
};

__device__ __forceinline__ XcdBarrier xcd_barrier_post(unsigned* bar, volatile LAS unsigned* st) {
    XcdBarrier b; b.bar = bar; b.x = xb_xcc_id(); b.st = st;
    if (threadIdx.x == 0) (void)xb_add(&bar[XB_XCNT(b.x)], 1u);
    return b;
}
__device__ __forceinline__ void xcd_barrier_complete(unsigned* bar, unsigned x, unsigned& nloc, unsigned& nx) {
    const unsigned G = gridDim.x * gridDim.y * gridDim.z;
    unsigned sum, cnt, mine, sp = 0u;
    for (;;) {
        sum = 0u; cnt = 0u; mine = 0u;
#pragma unroll
        for (unsigned j = 0; j < 16; ++j) { const unsigned c = xb_ld(&bar[XB_XCNT(j)]); sum += c; cnt += (c > 0u) ? 1u : 0u; mine = (j == x) ? c : mine; }
        if (sum == G) break;
        __builtin_amdgcn_s_sleep(1);
        if ((++sp & 255u) == 0u) { if (xb_ld(&bar[XB_TMO])) break; if (sp > XB_SPIN_CAP) { atomicAdd(&bar[XB_TMO], 1u); break; } }
    }
    nloc = mine > 0u ? mine : 1u; nx = cnt > 0u ? cnt : 1u;
}

__device__ __forceinline__ void xcd_barrier(const XcdBarrier& b) {
    asm volatile("s_waitcnt vmcnt(0)" ::: "memory");
    __syncthreads();
    if (threadIdx.x == 0) {
        unsigned* bar = b.bar;
        __builtin_amdgcn_s_waitcnt(0);
        unsigned nloc = b.st[0], nx = b.st[1];
        if (nloc == 0u) { xcd_barrier_complete(bar, b.x, nloc, nx); b.st[0] = nloc; b.st[1] = nx; }
        const unsigned old = xb_add(&bar[XB_XSUB(b.x)], 1u);
        const unsigned gen = old / nloc;
        if (old + 1u == (gen + 1u) * nloc) {
            __builtin_amdgcn_fence(__ATOMIC_RELEASE, "agent");
            asm volatile("s_waitcnt vmcnt(0)" ::: "memory");
            const unsigned og = xb_add(&bar[XB_TOP], 1u);
            const unsigned tg = og / nx;
            if (og + 1u == (tg + 1u) * nx) xb_add(&bar[XB_TOPGEN], 1u);
            else XB_SPIN(xb_ld(&bar[XB_TOPGEN]) == tg, bar);
            __builtin_amdgcn_fence(__ATOMIC_ACQUIRE, "agent");
            xb_add(&bar[XB_XGEN(b.x)], 1u);
            asm volatile("s_waitcnt vmcnt(0)" ::: "memory");
        } else {
            XB_SPIN(xb_ld(&bar[XB_XGEN(b.x)]) == gen, bar);
            __builtin_amdgcn_fence(__ATOMIC_ACQUIRE, "agent");
            asm volatile("s_waitcnt vmcnt(0)" ::: "memory");
        }
    }
    __syncthreads();
}

typedef unsigned short bf16_t;
typedef unsigned u32x4_t __attribute__((ext_vector_type(4)));
typedef unsigned u32x2_t __attribute__((ext_vector_type(2)));
typedef float f32x4_t __attribute__((ext_vector_type(4)));
constexpr int NB = 4, SEQ = 4096, DM = 2048, MTOK = NB * SEQ, DEPTH = 4, DFF = 8192;
constexpr int LDP = 13312, IN_COLS = 13088;
constexpr int COL_AQ = 0, COL_AK = 768, COL_AV = 1536, COL_BQ = 2304, COL_BK = 3328, COL_BV = 3584, COL_CQK = 3840, COL_CV = 4864, COL_CO = 5888, COL_G = 6912, COL_GATE = 13056;
constexpr int OCOL_GATE = 6912, OCOL_G = 6944;
constexpr float EPS = 1e-6f;
constexpr size_t al256(size_t x) { return (x + 255) / 256 * 256; }
constexpr size_t WS_CTRL = 0;
constexpr size_t WS_WT_IN = 16384;
constexpr size_t SZ_WT_IN = (size_t)LDP * DM * 2;
constexpr size_t WS_WT_A = WS_WT_IN + DEPTH * SZ_WT_IN;
constexpr size_t SZ_WT_A = (size_t)DM * 768 * 2;
constexpr int YK = 2816;
constexpr size_t SZ_WT_CAT = (size_t)DM * YK * 2;
constexpr size_t WS_WT_B = WS_WT_A + DEPTH * SZ_WT_A;
constexpr size_t SZ_WT_B = (size_t)DM * 1024 * 2;
constexpr size_t WS_WT_C = WS_WT_B + DEPTH * SZ_WT_B;
constexpr size_t WS_WT_OUT = WS_WT_C + DEPTH * SZ_WT_B;
constexpr size_t SZ_WT_OUT = (size_t)DM * DM * 2;
constexpr size_t WS_WT_UP = WS_WT_OUT + DEPTH * SZ_WT_OUT;
constexpr size_t SZ_WT_UP = (size_t)DFF * DM * 2;
constexpr size_t WS_WT_DOWN = WS_WT_UP + DEPTH * SZ_WT_UP;
constexpr size_t WS_ROPE1 = WS_WT_DOWN + DEPTH * SZ_WT_UP;
constexpr size_t WS_ROPEAX = WS_ROPE1 + 2 * (size_t)SEQ * 64 * 4;
constexpr size_t WS_XN = al256(WS_ROPEAX + 2 * 64 * 32 * 4);
constexpr size_t WS_P = WS_XN + (size_t)MTOK * DM * 2;
constexpr size_t WS_GATES = WS_P + (size_t)MTOK * LDP * 2;
constexpr size_t WS_CQ = WS_GATES + (size_t)MTOK * 32 * 4;
constexpr size_t WS_CK = WS_CQ + (size_t)MTOK * 512 * 2;
constexpr size_t WS_GA = WS_CK + (size_t)MTOK * 512 * 2;
constexpr size_t WS_GM = WS_GA + 64 * (size_t)SEQ * 4;
constexpr size_t WS_GF = WS_GM + 64 * (size_t)SEQ * 4;
constexpr size_t WS_YA = WS_GF + 64 * (size_t)SEQ * 4;
constexpr size_t WS_YB = WS_YA + (size_t)MTOK * 768 * 2;
constexpr size_t WS_YC = WS_YB + (size_t)MTOK * 1024 * 2;
constexpr size_t WS_SBUF = WS_YC + (size_t)MTOK * 1024 * 2;
constexpr size_t WS_NBUF = WS_SBUF + (size_t)4096 * 8192 * 4;
constexpr size_t WS_MERGED = WS_NBUF + (size_t)4096 * 64 * 4;
constexpr size_t WS_OA = WS_MERGED + (size_t)MTOK * DM * 2;
constexpr size_t WS_LSE = WS_OA + 3 * (size_t)MTOK * 768 * 2;
constexpr size_t WS_KT = al256(WS_LSE + 3 * (size_t)MTOK * 6 * 4);
constexpr size_t WS_VT = WS_KT + (size_t)MTOK * 512 * 2;
constexpr size_t WS_STATS = WS_VT + (size_t)MTOK * 1024 * 2;
constexpr size_t WS_END = WS_STATS + (size_t)MTOK * 32 * 4;

struct Params {
    const float* x; const float* norm1_g; const float* w_in; const float* a_q_gain; const float* a_k_gain; const float* b_q_gain; const float* b_k_gain;
    const float* c_conv_w; const float* c_conv_b; const float* c_gate_b; const float* c_out_g; const float* w_a; const float* w_b; const float* w_c;
    const float* w_out; const float* norm2_g; const float* w_up; const float* w_down;
    float* out; unsigned char* ws;
};

__device__ __forceinline__ float bf2f(bf16_t h) { return __uint_as_float((unsigned)h << 16); }
__device__ __forceinline__ bf16_t f2bf(float f) { return (bf16_t)(pg8::cvt_pk_bf16(f, 0.f) & 0xffffu); }
__device__ __forceinline__ float wave_sum(float v) {
#pragma unroll
    for (int o = 32; o >= 1; o >>= 1) v += __shfl_xor(v, o);
    return v;
}
__device__ __forceinline__ float wave_max(float v) {
#pragma unroll
    for (int o = 32; o >= 1; o >>= 1) v = fmaxf(v, __shfl_xor(v, o));
    return v;
}

constexpr int CVT_TPL = 17280, CVT_TILES = DEPTH * CVT_TPL;
__device__ __forceinline__ void cvt_wave_tile(const Params& p, int it, int lane) {
    constexpr int T0 = 3456, T1 = T0 + 3072, T2 = T1 + 128, T3 = T2 + 384, T4 = T3 + 512, T5 = T4 + 512, T6 = T5 + 1024, T7 = T6 + 4096, T8 = T7 + 4096;
    static_assert(T8 == CVT_TPL, "tile count");
        const int l = it / T8; int t = it % T8;
        const float* src; bf16_t* dst; int K, ld, col0, nsrc, ntn, ldd = 0; const float* gain = nullptr; bool panel = false, f16 = false;
        unsigned char* ws = p.ws;
        if (t < T0) { src = p.w_in + (size_t)l * DM * IN_COLS; dst = (bf16_t*)(ws + WS_WT_IN + l * SZ_WT_IN); K = DM; ld = IN_COLS; col0 = 0; nsrc = 6912; ntn = 108; gain = p.norm1_g + l * DM; panel = true; f16 = true; }
        else if (t < T1) { t -= T0; src = p.w_in + (size_t)l * DM * IN_COLS; dst = (bf16_t*)(ws + WS_WT_IN + l * SZ_WT_IN) + (size_t)COL_G * DM; K = DM; ld = IN_COLS; col0 = OCOL_G; nsrc = 6144; ntn = 96; gain = p.norm1_g + l * DM; panel = true; f16 = true; }
        else if (t < T2) { t -= T1; src = p.w_in + (size_t)l * DM * IN_COLS; dst = (bf16_t*)(ws + WS_WT_IN + l * SZ_WT_IN) + (size_t)COL_GATE * DM; K = DM; ld = IN_COLS; col0 = OCOL_GATE; nsrc = 32; ntn = 4; gain = p.norm1_g + l * DM; panel = true; f16 = true; }
        else if (t < T3) { t -= T2; src = p.w_a + (size_t)l * 768 * DM; dst = (bf16_t*)(ws + WS_WT_A + l * SZ_WT_CAT); K = 768; ld = DM; col0 = 0; nsrc = DM; ntn = 32; ldd = YK; }
        else if (t < T4) { t -= T3; src = p.w_b + (size_t)l * 1024 * DM; dst = (bf16_t*)(ws + WS_WT_A + l * SZ_WT_CAT) + 768; K = 1024; ld = DM; col0 = 0; nsrc = DM; ntn = 32; ldd = YK; }
        else if (t < T5) { t -= T4; src = p.w_c + (size_t)l * 1024 * DM; dst = (bf16_t*)(ws + WS_WT_A + l * SZ_WT_CAT) + 1792; K = 1024; ld = DM; col0 = 0; nsrc = DM; ntn = 32; ldd = YK; }
        else if (t < T6) { t -= T5; src = p.w_out + (size_t)l * DM * DM; dst = (bf16_t*)(ws + WS_WT_OUT + l * SZ_WT_OUT); K = DM; ld = DM; col0 = 0; nsrc = DM; ntn = 32; }
        else if (t < T7) { t -= T6; src = p.w_up + (size_t)l * DM * DFF; dst = (bf16_t*)(ws + WS_WT_UP + l * SZ_WT_UP); K = DM; ld = DFF; col0 = 0; nsrc = DFF; ntn = 128; gain = p.norm2_g + l * DM; panel = true; f16 = true; }
        else { t -= T7; src = p.w_down + (size_t)l * DFF * DM; dst = (bf16_t*)(ws + WS_WT_DOWN + l * SZ_WT_UP); K = DFF; ld = DM; col0 = 0; nsrc = DM; ntn = 32; panel = true; }
        const int tk = t / ntn, tn = t % ntn, kg = lane & 7, ng = lane >> 3;
        const int n = tn * 64 + 8 * ng, k0 = tk * 64 + 8 * kg; const bool valid = n < nsrc;
        float v[8][8];
#pragma unroll
        for (int i = 0; i < 8; ++i) { f32x4_t a = {0.f, 0.f, 0.f, 0.f}, b = {0.f, 0.f, 0.f, 0.f};
            if (valid) { const float* sp = src + (size_t)(k0 + i) * ld + col0 + n; a = *(const f32x4_t*)sp; b = *(const f32x4_t*)(sp + 4); }
            const float gk = gain ? gain[k0 + i] : 1.0f;
            v[i][0] = a[0] * gk; v[i][1] = a[1] * gk; v[i][2] = a[2] * gk; v[i][3] = a[3] * gk; v[i][4] = b[0] * gk; v[i][5] = b[1] * gk; v[i][6] = b[2] * gk; v[i][7] = b[3] * gk; }
        const int rs = ldd ? ldd : K;
#pragma unroll
        for (int j = 0; j < 8; ++j) { const int ng_ = n + j;
            u32x4_t w;
            if (f16) { w.x = pg8::cvt_pk_f16(v[0][j], v[1][j]); w.y = pg8::cvt_pk_f16(v[2][j], v[3][j]); w.z = pg8::cvt_pk_f16(v[4][j], v[5][j]); w.w = pg8::cvt_pk_f16(v[6][j], v[7][j]); }
            else { w.x = pg8::cvt_pk_bf16(v[0][j], v[1][j]); w.y = pg8::cvt_pk_bf16(v[2][j], v[3][j]); w.z = pg8::cvt_pk_bf16(v[4][j], v[5][j]); w.w = pg8::cvt_pk_bf16(v[6][j], v[7][j]); }
            if (panel) *(u32x4_t*)(dst + ((size_t)(ng_ >> 8) * (K / 64) + tk) * 16384 + (ng_ & 255) * 64 + 8 * kg) = w;
            else *(u32x4_t*)(dst + (size_t)ng_ * rs + k0) = w; }
}
__device__ __forceinline__ void ph_tables(const Params& p, int bid, int nblk) {
    float* c1 = (float*)(p.ws + WS_ROPE1); float* s1 = c1 + SEQ * 64;
    const int tid0 = tid_l();
    for (int i = bid * 512 + tid0; i < SEQ * 64; i += nblk * 512) {
        const int pos = i >> 6, f = i & 63;
        const float inv = powf(10000.0f, -(float)(2 * f) / 128.0f); const float ang = (float)pos * inv;
        float sn, cs; sincosf(ang, &sn, &cs); c1[i] = cs; s1[i] = sn;
    }
    float* ca = (float*)(p.ws + WS_ROPEAX); float* sa = ca + 64 * 32;
    for (int i = bid * 512 + tid0; i < 64 * 32; i += nblk * 512) {
        const int pos = i >> 5, f = i & 31;
        const float inv = powf(10000.0f, -(float)(2 * f) / 64.0f); const float ang = (float)pos * inv;
        float sn, cs; sincosf(ang, &sn, &cs); ca[i] = cs; sa[i] = sn;
    }
}

__device__ __forceinline__ void ph_xprep(const float* __restrict__ X, bf16_t* __restrict__ O, unsigned long long* __restrict__ stats, int bid, int nblk) {
    const int tid = tid_l(); const int wid = tid >> 6, lane = tid & 63;
    for (int row = bid * 8 + wid; row < MTOK; row += nblk * 8) {
        const f32x4_t* xr = (const f32x4_t*)(X + (size_t)row * DM);
        f32x4_t v[8]; float ss = 0.f;
#pragma unroll
        for (int i = 0; i < 8; ++i) { v[i] = xr[lane + 64 * i]; ss += v[i][0] * v[i][0] + v[i][1] * v[i][1] + v[i][2] * v[i][2] + v[i][3] * v[i][3]; }
        ss = wave_sum(ss);
#pragma unroll
        for (int i = 0; i < 8; ++i) { u32x2_t w; w.x = pg8::cvt_pk_f16(v[i][0], v[i][1]); w.y = pg8::cvt_pk_f16(v[i][2], v[i][3]); const int c = (lane + 64 * i) * 4; *(u32x2_t*)(O + ((size_t)(row >> 8) * (DM / 64) + (c >> 6)) * 16384 + (row & 255) * 64 + (c & 63)) = w; }
        if (lane == 0) stats[row] = (unsigned long long)(ss * pg8::SS_SCALE + 0.5f);
    }
}

struct QkItem { u32x4_t w1, w2; f32x4_t ga, gb, gc, gd, ca0, ca1, sa0, sa1; bf16_t* p1; bf16_t* p2; };
__device__ __forceinline__ void qk_load(QkItem& q, const LAS float* gl, bf16_t* P, const float* c1, const float* s1, const float* ca, const float* sa, int item, int j) {
    const int row = item / 22, hi = item % 22, t = row & (SEQ - 1);
    int cb; const LAS float* gain; bool axial;
    if (hi < 6) { cb = COL_AQ + hi * 128; gain = gl; axial = false; }
    else if (hi < 12) { cb = COL_AK + (hi - 6) * 128; gain = gl + 128; axial = false; }
    else if (hi < 20) { cb = COL_BQ + (hi - 12) * 128; gain = gl + 256; axial = true; }
    else { cb = COL_BK + (hi - 20) * 128; gain = gl + 384; axial = true; }
    const int e1 = axial ? 8 * j + (j >= 4 ? 32 : 0) : 8 * j, e2 = e1 + (axial ? 32 : 64);
    const float* ct; const float* st;
    if (!axial) { ct = c1 + t * 64 + 8 * j; st = s1 + t * 64 + 8 * j; }
    else { const int pi = j < 4 ? (t >> 6) : (t & 63); ct = ca + pi * 32 + 8 * (j & 3); st = sa + pi * 32 + 8 * (j & 3); }
    bf16_t* pr = P + (size_t)row * LDP + cb; q.p1 = pr + e1; q.p2 = pr + e2;
    q.w1 = *(const u32x4_t*)q.p1; q.w2 = *(const u32x4_t*)q.p2;
    q.ga = *(const LAS f32x4_t*)(gain + e1); q.gb = *(const LAS f32x4_t*)(gain + e1 + 4); q.gc = *(const LAS f32x4_t*)(gain + e2); q.gd = *(const LAS f32x4_t*)(gain + e2 + 4);
    q.ca0 = *(const f32x4_t*)(ct); q.ca1 = *(const f32x4_t*)(ct + 4); q.sa0 = *(const f32x4_t*)(st); q.sa1 = *(const f32x4_t*)(st + 4);
}
__device__ __forceinline__ void qk_finish(const QkItem& q) {
    const u32x4_t w1 = q.w1, w2 = q.w2;
    const float x1[8] = {pg8::bf_lo(w1.x), pg8::bf_hi(w1.x), pg8::bf_lo(w1.y), pg8::bf_hi(w1.y), pg8::bf_lo(w1.z), pg8::bf_hi(w1.z), pg8::bf_lo(w1.w), pg8::bf_hi(w1.w)};
    const float x2[8] = {pg8::bf_lo(w2.x), pg8::bf_hi(w2.x), pg8::bf_lo(w2.y), pg8::bf_hi(w2.y), pg8::bf_lo(w2.z), pg8::bf_hi(w2.z), pg8::bf_lo(w2.w), pg8::bf_hi(w2.w)};
    const float g1[8] = {q.ga[0], q.ga[1], q.ga[2], q.ga[3], q.gb[0], q.gb[1], q.gb[2], q.gb[3]}, g2[8] = {q.gc[0], q.gc[1], q.gc[2], q.gc[3], q.gd[0], q.gd[1], q.gd[2], q.gd[3]};
    const float cs[8] = {q.ca0[0], q.ca0[1], q.ca0[2], q.ca0[3], q.ca1[0], q.ca1[1], q.ca1[2], q.ca1[3]}, sn[8] = {q.sa0[0], q.sa0[1], q.sa0[2], q.sa0[3], q.sa1[0], q.sa1[1], q.sa1[2], q.sa1[3]};
    float ss = 0.f;
#pragma unroll
    for (int i = 0; i < 8; ++i) ss += x1[i] * x1[i] + x2[i] * x2[i];
    ss += __shfl_xor(ss, 1); ss += __shfl_xor(ss, 2); ss += __shfl_xor(ss, 4);
    const float r = rsqrtf(ss * (1.0f / 128.0f) + EPS);
    float o1[8], o2[8];
#pragma unroll
    for (int i = 0; i < 8; ++i) { const float n1 = x1[i] * r * g1[i], n2 = x2[i] * r * g2[i]; o1[i] = n1 * cs[i] - n2 * sn[i]; o2[i] = n2 * cs[i] + n1 * sn[i]; }
    u32x4_t q1, q2;
    q1.x = pg8::cvt_pk_bf16(o1[0], o1[1]); q1.y = pg8::cvt_pk_bf16(o1[2], o1[3]); q1.z = pg8::cvt_pk_bf16(o1[4], o1[5]); q1.w = pg8::cvt_pk_bf16(o1[6], o1[7]);
    q2.x = pg8::cvt_pk_bf16(o2[0], o2[1]); q2.y = pg8::cvt_pk_bf16(o2[2], o2[3]); q2.z = pg8::cvt_pk_bf16(o2[4], o2[5]); q2.w = pg8::cvt_pk_bf16(o2[6], o2[7]);
    *(u32x4_t*)q.p1 = q1; *(u32x4_t*)q.p2 = q2;
}
__device__ __forceinline__ void conv_wave_item(const Params& p, int layer, int witem, int lane) {
    const bf16_t* P = (const bf16_t*)(p.ws + WS_P);
    bf16_t* cq = (bf16_t*)(p.ws + WS_CQ); bf16_t* ck = (bf16_t*)(p.ws + WS_CK); bf16_t* Kt = (bf16_t*)(p.ws + WS_KT);
    const float* cw = p.c_conv_w + (size_t)layer * 5 * 1024; const float* cbias = p.c_conv_b + (size_t)layer * 1024;
        const int half = witem >> 11, cidx = (witem & 2047) >> 3, pg = witem & 7, b = cidx >> 6, pc = cidx & 63;
        const int c8 = lane * 8, ch = half * 512 + c8, t0 = pc * 64 + pg * 8; const size_t row0 = (size_t)b * SEQ + t0;
        float x[12][8];
#pragma unroll
        for (int r = 0; r < 12; ++r) { const int tt = t0 + r - 2; u32x4_t w = {0u, 0u, 0u, 0u};
            if (tt >= 0 && tt < SEQ) w = *(const u32x4_t*)(P + (row0 + r - 2) * LDP + COL_CQK + ch);
            x[r][0] = pg8::bf_lo(w.x); x[r][1] = pg8::bf_hi(w.x); x[r][2] = pg8::bf_lo(w.y); x[r][3] = pg8::bf_hi(w.y); x[r][4] = pg8::bf_lo(w.z); x[r][5] = pg8::bf_hi(w.z); x[r][6] = pg8::bf_lo(w.w); x[r][7] = pg8::bf_hi(w.w); }
        float wt[5][8], bs[8];
#pragma unroll
        for (int j = 0; j < 5; ++j) { const f32x4_t wa = *(const f32x4_t*)(cw + j * 1024 + ch), wb = *(const f32x4_t*)(cw + j * 1024 + ch + 4);
            wt[j][0] = wa[0]; wt[j][1] = wa[1]; wt[j][2] = wa[2]; wt[j][3] = wa[3]; wt[j][4] = wb[0]; wt[j][5] = wb[1]; wt[j][6] = wb[2]; wt[j][7] = wb[3]; }
        { const f32x4_t b0 = *(const f32x4_t*)(cbias + ch), b1 = *(const f32x4_t*)(cbias + ch + 4); bs[0] = b0[0]; bs[1] = b0[1]; bs[2] = b0[2]; bs[3] = b0[3]; bs[4] = b1[0]; bs[5] = b1[1]; bs[6] = b1[2]; bs[7] = b1[3]; }
        const float sc = half ? 0.125f : 1.0f;
        unsigned yk[8][4];
#pragma unroll
        for (int q = 0; q < 8; ++q) { float y[8];
#pragma unroll
            for (int i = 0; i < 8; ++i) { float a = bs[i];
#pragma unroll
                for (int j = 0; j < 5; ++j) a += wt[j][i] * x[q + j][i];
                y[i] = a * pg8::sigmoidf_(a) * sc; }
            yk[q][0] = pg8::cvt_pk_bf16(y[0], y[1]); yk[q][1] = pg8::cvt_pk_bf16(y[2], y[3]); yk[q][2] = pg8::cvt_pk_bf16(y[4], y[5]); yk[q][3] = pg8::cvt_pk_bf16(y[6], y[7]);
            const u32x4_t w = {yk[q][0], yk[q][1], yk[q][2], yk[q][3]};
            if (!half) *(u32x4_t*)(cq + (row0 + q) * 512 + c8) = w; else *(u32x4_t*)(ck + (row0 + q) * 512 + c8) = w; }
        if (half) {
            const int hh = c8 >> 6, d0 = c8 & 63;
#pragma unroll
            for (int i = 0; i < 8; ++i) { u32x4_t o;
                const int wsel = i >> 1;
#define KT_PICK(q) ((i & 1) ? (yk[q][wsel] >> 16) : (yk[q][wsel] & 0xffffu))
                o.x = KT_PICK(0) | (KT_PICK(1) << 16); o.y = KT_PICK(2) | (KT_PICK(3) << 16); o.z = KT_PICK(4) | (KT_PICK(5) << 16); o.w = KT_PICK(6) | (KT_PICK(7) << 16);
#undef KT_PICK
                *(u32x4_t*)(Kt + (size_t)((b * 8 + hh) * 64 + d0 + i) * SEQ + t0) = o; }
        }
}
__device__ __forceinline__ void ph_thin(const Params& p, int layer, int bid, int nblk, char* lds) {
    const int tid = tid_l(); const int wid = tid >> 6, lane = tid & 63;
    bf16_t* P = (bf16_t*)(p.ws + WS_P);
    const float* c1 = (const float*)(p.ws + WS_ROPE1); const float* s1 = c1 + SEQ * 64;
    const float* ca = (const float*)(p.ws + WS_ROPEAX); const float* sa = ca + 64 * 32;
    { unsigned long long* st = (unsigned long long*)(p.ws + WS_STATS); for (int i = bid * 512 + tid; i < 2 * MTOK; i += nblk * 512) st[i] = 0ull; }
    LAS float* gl = (LAS float*)(lds + 1024);
    { const int t7 = tid & 127, ty = tid >> 7; float gv;
      if (ty == 0) gv = p.a_q_gain[layer * 128 + t7]; else if (ty == 1) gv = p.a_k_gain[layer * 128 + t7]; else if (ty == 2) gv = p.b_q_gain[layer * 128 + t7]; else gv = p.b_k_gain[layer * 128 + t7];
      gl[tid] = gv; }
    __syncthreads();
    { const int j = lane & 7, sub = lane >> 3; constexpr int NIG = MTOK * 22 / 8; const int stride = nblk * 8;
      int ig = bid * 8 + wid;
      QkItem qa; qk_load(qa, gl, P, c1, s1, ca, sa, (ig < NIG ? ig : 0) * 8 + sub, j);
      for (; ig < NIG; ig += stride) {
        QkItem qb; const int ign = ig + stride;
        qk_load(qb, gl, P, c1, s1, ca, sa, (ign < NIG ? ign : ig) * 8 + sub, j);
        qk_finish(qa);
        qa = qb;
      }
    }
    bf16_t* Vt = (bf16_t*)(p.ws + WS_VT);
    for (int w = 2048 + bid * 8 + wid; w < 4096; w += nblk * 8) conv_wave_item(p, layer, w, lane);
    for (int item = bid; item < 512; item += nblk) {
        const int half = item >> 8, cidx = item & 255, b = cidx >> 6, pc = cidx & 63;
        const int pg = tid >> 6, c8 = (tid & 63) * 8, ch = half * 512 + c8, t0 = pc * 64 + pg * 8; const size_t row0 = (size_t)b * SEQ + t0;
        unsigned yk[8][4];
#pragma unroll
        for (int q = 0; q < 8; ++q) { const u32x4_t w = *(const u32x4_t*)(P + (row0 + q) * LDP + COL_CV + ch); yk[q][0] = w.x; yk[q][1] = w.y; yk[q][2] = w.z; yk[q][3] = w.w; }
        const int hh = ch >> 7, v0 = ch & 127;
#pragma unroll
        for (int i = 0; i < 8; ++i) { u32x4_t o; const int wsel = i >> 1;
#define VT_PICK(q) ((i & 1) ? (yk[q][wsel] >> 16) : (yk[q][wsel] & 0xffffu))
            o.x = VT_PICK(0) | (VT_PICK(1) << 16); o.y = VT_PICK(2) | (VT_PICK(3) << 16); o.z = VT_PICK(4) | (VT_PICK(5) << 16); o.w = VT_PICK(6) | (VT_PICK(7) << 16);
#undef VT_PICK
            *(u32x4_t*)(Vt + (size_t)((b * 8 + hh) * 128 + v0 + i) * SEQ + t0) = o; }
    }
}

__device__ __forceinline__ float log_sigmoid(float x) { return fminf(x, 0.f) - log1pf(__expf(-fabsf(x))); }
__device__ __forceinline__ float scan_add64(float s, int lane) {
#pragma unroll
    for (int o = 1; o < 64; o <<= 1) { const float n = __shfl_up(s, o); if (lane >= o) s += n; }
    return s;
}
__device__ __forceinline__ float scan_max64(float s, int lane) {
#pragma unroll
    for (int o = 1; o < 64; o <<= 1) { const float n = __shfl_up(s, o); if (lane >= o) s = fmaxf(s, n); }
    return s;
}
__device__ __forceinline__ void ph_gatescan(const Params& p, int layer, int bid, int nblk, char* lds) {
    const int tid = tid_l(); const int wid = tid >> 6, lane = tid & 63;
    const float* G = (const float*)(p.ws + WS_GATES); const float* gb = p.c_gate_b + layer * 32;
    float* gA = (float*)(p.ws + WS_GA); float* gM = (float*)(p.ws + WS_GM); float* gF = (float*)(p.ws + WS_GF);
    float* wt = (float*)lds;
    for (int sq = bid; sq < 64; sq += nblk) {
        const int dir = sq & 1, h = (sq >> 1) & 7, b = sq >> 4;
        const int ci = (2 * dir) * 8 + h, cf = (2 * dir + 1) * 8 + h;
        const float bi = gb[ci], bfb = gb[cf];
        float F[8], a[8];
#pragma unroll
        for (int k = 0; k < 8; ++k) { const int idx = tid * 8 + k, pos = dir ? SEQ - 1 - idx : idx; const size_t gr = (size_t)(b * SEQ + pos) * 32; F[k] = G[gr + cf]; a[k] = G[gr + ci]; }
        float run = 0.f;
#pragma unroll
        for (int k = 0; k < 8; ++k) { run += log_sigmoid(F[k] + bfb); F[k] = run; }
        const float inc = scan_add64(run, lane);
        __syncthreads();
        if (lane == 63) wt[wid] = inc;
        __syncthreads();
        float off = inc - run;
#pragma unroll
        for (int w = 0; w < 8; ++w) if (w < wid) off += wt[w];
        float mx = -1e30f;
#pragma unroll
        for (int k = 0; k < 8; ++k) { F[k] += off; a[k] = (a[k] + bi) - F[k]; mx = fmaxf(mx, a[k]); }
        const float incm = scan_max64(mx, lane);
        if (lane == 63) wt[8 + wid] = incm;
        __syncthreads();
        float carry = __shfl_up(incm, 1); if (lane == 0) carry = 0.f;
        carry = fmaxf(carry, 0.f);
#pragma unroll
        for (int w = 0; w < 8; ++w) if (w < wid) carry = fmaxf(carry, wt[8 + w]);
        float M[8];
#pragma unroll
        for (int k = 0; k < 8; ++k) { carry = fmaxf(carry, a[k]); M[k] = carry; }
        const size_t o = (size_t)sq * SEQ + tid * 8;
        *(f32x4_t*)(gF + o) = (f32x4_t){F[0], F[1], F[2], F[3]}; *(f32x4_t*)(gF + o + 4) = (f32x4_t){F[4], F[5], F[6], F[7]};
        *(f32x4_t*)(gA + o) = (f32x4_t){a[0], a[1], a[2], a[3]}; *(f32x4_t*)(gA + o + 4) = (f32x4_t){a[4], a[5], a[6], a[7]};
        *(f32x4_t*)(gM + o) = (f32x4_t){M[0], M[1], M[2], M[3]}; *(f32x4_t*)(gM + o + 4) = (f32x4_t){M[4], M[5], M[6], M[7]};
    }
}

namespace att {
using bf16x8 = __attribute__((ext_vector_type(8))) short;
using s16x4  = __attribute__((ext_vector_type(4))) short;
using f32x16 = __attribute__((ext_vector_type(16))) float;
using u32x4  = __attribute__((ext_vector_type(4))) unsigned;
constexpr int D = 128, NW = 8, QBLK = 32, KVBLK = 64;
constexpr float SCALE = 0.088388347648318440f;
constexpr float THR = 8.f;
constexpr size_t SHM_V = KVBLK * D * 2, SHM_K = KVBLK * D * 2, SHM_ATTN = 2 * SHM_V + 2 * SHM_K + NW * 64 * 4;
#define KSWZ(row, colB) ((row) * 256 + ((colB) ^ (((row) & 7) << 4)))
#define SBAR() __builtin_amdgcn_sched_barrier(0)
__device__ __forceinline__ int crow(int r, int hi) { return (r & 3) + 8 * (r >> 2) + 4 * hi; }
__device__ __forceinline__ unsigned cvtpk(float lo, float hi) { unsigned r; asm volatile("v_cvt_pk_bf16_f32 %0, %1, %2" : "=v"(r) : "v"(lo), "v"(hi)); return r; }

__device__ __forceinline__ void partialSM(f32x16& p0, f32x16& p1, float& m_reg, float& mn, float& alpha) {
  constexpr float C = SCALE * 1.4426950408889634f;
  float pmax = p0[0]; for (int r = 1; r < 16; ++r) pmax = fmaxf(pmax, p0[r]); for (int r = 0; r < 16; ++r) pmax = fmaxf(pmax, p1[r]);
  { auto rr = __builtin_amdgcn_permlane32_swap(__float_as_uint(pmax), __float_as_uint(pmax), false, false);
    pmax = fmaxf(__uint_as_float(rr[0]), __uint_as_float(rr[1])); }
  if (__builtin_expect(__all(pmax - m_reg <= THR / SCALE), 1)) { mn = m_reg; alpha = 1.f; }
  else { mn = fmaxf(m_reg, pmax); alpha = __builtin_amdgcn_exp2f((m_reg - mn) * C); m_reg = mn; }
  float mnC = -mn * C;
  for (int r = 0; r < 16; ++r) p0[r] = fmaf(p0[r], C, mnC); for (int r = 0; r < 16; ++r) p1[r] = fmaf(p1[r], C, mnC);
  for (int r = 0; r < 16; ++r) p0[r] = __builtin_amdgcn_exp2f(p0[r]);
}
__device__ __forceinline__ void finishSM(f32x16& p0, f32x16& p1, float alpha, float& l_reg, bf16x8& pa0, bf16x8& pa1, bf16x8& pa2, bf16x8& pa3) {
  for (int r = 0; r < 16; ++r) p1[r] = __builtin_amdgcn_exp2f(p1[r]);
  float ps = 0; for (int r = 0; r < 16; ++r) ps += p0[r]; for (int r = 0; r < 16; ++r) ps += p1[r];
  { auto rr = __builtin_amdgcn_permlane32_swap(__float_as_uint(ps), __float_as_uint(ps), false, false);
    ps = __uint_as_float(rr[0]) + __uint_as_float(rr[1]); }
  l_reg = l_reg * alpha + ps;
#define PK4(P, BASE, OUT) do { unsigned a0 = cvtpk(P[BASE + 0], P[BASE + 1]), a1 = cvtpk(P[BASE + 2], P[BASE + 3]);   \
    unsigned b0 = cvtpk(P[BASE + 4], P[BASE + 5]), b1 = cvtpk(P[BASE + 6], P[BASE + 7]);                              \
    auto r0 = __builtin_amdgcn_permlane32_swap(a0, b0, false, false); auto r1 = __builtin_amdgcn_permlane32_swap(a1, b1, false, false); \
    u32x4 w = {r0[0], r1[0], r0[1], r1[1]}; OUT = *reinterpret_cast<bf16x8*>(&w); } while (0)
  PK4(p0, 0, pa0); PK4(p0, 8, pa1); PK4(p1, 0, pa2); PK4(p1, 8, pa3);
#undef PK4
}
__device__ __forceinline__ void qkt(f32x16& p0, f32x16& p1, const bf16_t* Ks, const bf16x8* qr, int r32, int hi) {
  p0 = f32x16{}; p1 = f32x16{};
  for (int d0 = 0; d0 < 8; ++d0) { int cb = (d0 * 16 + hi * 8) * 2;
    bf16x8 b0 = *reinterpret_cast<const bf16x8*>((const char*)Ks + KSWZ(r32, cb));
    bf16x8 b1 = *reinterpret_cast<const bf16x8*>((const char*)Ks + KSWZ(32 + r32, cb));
    p0 = __builtin_amdgcn_mfma_f32_32x32x16_bf16(b0, qr[d0], p0, 0, 0, 0);
    p1 = __builtin_amdgcn_mfma_f32_32x32x16_bf16(b1, qr[d0], p1, 0, 0, 0); }
}
__device__ __forceinline__ void maskband(f32x16& p0, f32x16& p1, int kb_minus_qi, int hi) {
  const float ninf = -__builtin_inff();
#pragma unroll
  for (int r = 0; r < 16; ++r) { const int d0 = kb_minus_qi + crow(r, hi);
    p0[r] = ((unsigned)(d0 + 64) <= 128u) ? p0[r] : ninf; p1[r] = ((unsigned)(d0 + 32 + 64) <= 128u) ? p1[r] : ninf; }
}
__device__ __forceinline__ int v_st(int k, int c) { const int kk = (k & ~0xC) | ((k & 4) << 1) | ((k & 8) >> 1); return ((kk >> 3) * 4 + (c >> 5)) * 512 + ((kk & 7) * 32 + (c & 31)) * 2; }
__device__ __forceinline__ int v_rd_base(int lane) { return ((lane & 3) << 3) | (((lane >> 2) & 3) << 6) | (((lane >> 4) & 1) << 5) | (((lane >> 5) & 1) << 8); }
constexpr int v_rd_off(int d0, int ks, int half) { return d0 * 512 + ks * 4096 + half * 2048; }
template <int OFF> __device__ __forceinline__ s16x4 tr_read(int vb) {
  s16x4 r; asm volatile("ds_read_b64_tr_b16 %0, %1 offset:%2" : "=&v"(r) : "v"(vb), "i"(OFF) : "memory"); return r;
}
template <int D0> __device__ __forceinline__ void pv_one(f32x16& od, int vb, bf16x8 pa0, bf16x8 pa1, bf16x8 pa2, bf16x8 pa3) {
  const s16x4 l0 = tr_read<v_rd_off(D0, 0, 0)>(vb), h0 = tr_read<v_rd_off(D0, 0, 1)>(vb), l1 = tr_read<v_rd_off(D0, 1, 0)>(vb), h1 = tr_read<v_rd_off(D0, 1, 1)>(vb);
  const s16x4 l2 = tr_read<v_rd_off(D0, 2, 0)>(vb), h2 = tr_read<v_rd_off(D0, 2, 1)>(vb), l3 = tr_read<v_rd_off(D0, 3, 0)>(vb), h3 = tr_read<v_rd_off(D0, 3, 1)>(vb);
  asm volatile("s_waitcnt lgkmcnt(0)" ::: "memory"); SBAR();
#define PK(L, H) (bf16x8){L[0], L[1], L[2], L[3], H[0], H[1], H[2], H[3]}
  od = __builtin_amdgcn_mfma_f32_32x32x16_bf16(pa0, PK(l0, h0), od, 0, 0, 0);
  od = __builtin_amdgcn_mfma_f32_32x32x16_bf16(pa1, PK(l1, h1), od, 0, 0, 0);
  od = __builtin_amdgcn_mfma_f32_32x32x16_bf16(pa2, PK(l2, h2), od, 0, 0, 0);
  od = __builtin_amdgcn_mfma_f32_32x32x16_bf16(pa3, PK(l3, h3), od, 0, 0, 0);
#undef PK
}
__device__ __forceinline__ void pv_d0(f32x16* o, int vb, bf16x8 pa0, bf16x8 pa1, bf16x8 pa2, bf16x8 pa3) {
  pv_one<0>(o[0], vb, pa0, pa1, pa2, pa3); pv_one<1>(o[1], vb, pa0, pa1, pa2, pa3); pv_one<2>(o[2], vb, pa0, pa1, pa2, pa3); pv_one<3>(o[3], vb, pa0, pa1, pa2, pa3);
}

template <bool BAND, int SDEPTH>
__device__ __forceinline__ void attn_body(const bf16_t* __restrict__ Qb, long ldq, const bf16_t* __restrict__ Kh, const bf16_t* __restrict__ Vh, long ldk,
                                          bf16_t* __restrict__ Ob, long ldo, float* __restrict__ lse_out, long ld_lse, int qi0, int kt0, int NT, char* lds) {
  const int tid = tid_l(), wid = tid >> 6, lane = tid & 63, r32 = lane & 31, hi = lane >> 5;
  bf16_t* V_lds = (bf16_t*)lds; bf16_t* K_lds = (bf16_t*)(lds + 2 * SHM_V);
  float* wsm = (float*)(lds + 2 * SHM_V + 2 * SHM_K) + wid * 64; float* li_l = wsm; float* al_l = wsm + 32;
  float m_reg = -1e30f, l_reg = 0; f32x16 o[4] = {}; bf16x8 qr[8];
  const bf16_t* Qw = Qb + (long)(wid * QBLK + r32) * ldq + hi * 8;
#pragma unroll
  for (int d0 = 0; d0 < 8; ++d0) qr[d0] = *reinterpret_cast<const bf16x8*>(Qw + d0 * 16);
  const int sr = tid >> 4, sc = (tid & 15) * 8, vst0 = v_st(sr, sc), vst1 = v_st(32 + sr, sc);
  const int vb0 = (int)(uintptr_t)V_lds + v_rd_base(lane);
  const int qi = qi0 + wid * QBLK + r32;
  struct { bf16x8 vs0, vs1, ks0, ks1; } sr_[SDEPTH] = {};
  const bf16_t* Kt = Kh + (long)(kt0 * KVBLK) * ldk; const bf16_t* Vt = Vh + (long)(kt0 * KVBLK) * ldk;
#define SLOAD(i, k0) do { sr_[i].vs0 = *reinterpret_cast<const bf16x8*>(&Vt[(long)((k0) + sr) * ldk + sc]); sr_[i].vs1 = *reinterpret_cast<const bf16x8*>(&Vt[(long)((k0) + 32 + sr) * ldk + sc]); \
    sr_[i].ks0 = *reinterpret_cast<const bf16x8*>(&Kt[(long)((k0) + sr) * ldk + sc]); sr_[i].ks1 = *reinterpret_cast<const bf16x8*>(&Kt[(long)((k0) + 32 + sr) * ldk + sc]); } while (0)
#define SWRITE(b, i) do { *(bf16x8*)((char*)V_lds + (b) * SHM_V + vst0) = sr_[i].vs0;          \
    *(bf16x8*)((char*)V_lds + (b) * SHM_V + vst1) = sr_[i].vs1; int kc = sc * 2;               \
    *(bf16x8*)((char*)K_lds + (b) * SHM_K + KSWZ(sr, kc)) = sr_[i].ks0;                       \
    *(bf16x8*)((char*)K_lds + (b) * SHM_K + KSWZ(32 + sr, kc)) = sr_[i].ks1; } while (0)
#define SWAIT() do { if constexpr (SDEPTH == 2) asm volatile("s_waitcnt vmcnt(4)" ::: "memory"); else asm volatile("s_waitcnt vmcnt(0)" ::: "memory"); } while (0)
#define RESC(a) do { if (__any((a) < 1.f)) { if (hi == 0) al_l[r32] = (a); asm volatile("s_waitcnt lgkmcnt(0)" ::: "memory"); \
    for (int d = 0; d < 4; ++d) for (int r = 0; r < 16; ++r) o[d][r] *= al_l[crow(r, hi)]; } } while (0)
#define MASK(P0, P1, j) do { if (BAND) maskband(P0, P1, (kt0 + (j)) * KVBLK - qi, hi); } while (0)
  f32x16 pA0 = {}, pA1 = {}, pB0 = {}, pB1 = {}; float mnA = 0.f, mnB = 0.f, alA = 1.f, alB = 1.f; bf16x8 pa0 = {}, pa1 = {}, pa2 = {}, pa3 = {};
  constexpr int SE = 0, SO = SDEPTH - 1;
  __syncthreads();
  SLOAD(SE, 0); asm volatile("s_waitcnt vmcnt(0)" ::: "memory"); SWRITE(0, SE); __syncthreads();
  qkt(pA0, pA1, K_lds, qr, r32, hi); MASK(pA0, pA1, 0); partialSM(pA0, pA1, m_reg, mnA, alA);
  SLOAD(SO, KVBLK); if constexpr (SDEPTH == 2) { if (2 < NT) SLOAD(SE, 2 * KVBLK); }
  SWAIT(); SWRITE(1, SO); __syncthreads();
  for (int j = 1; j + 1 < NT; j += 2) {
    SBAR(); qkt(pB0, pB1, (bf16_t*)((char*)K_lds + SHM_K), qr, r32, hi); MASK(pB0, pB1, j);
    finishSM(pA0, pA1, alA, l_reg, pa0, pa1, pa2, pa3); SBAR();
    SLOAD(SO, (j + SDEPTH) * KVBLK); SBAR();
    pv_d0(o, vb0, pa0, pa1, pa2, pa3); partialSM(pB0, pB1, m_reg, mnB, alB);
    __syncthreads(); SWAIT(); SWRITE(0, SE);
    RESC(alB); __syncthreads();
    SBAR(); qkt(pA0, pA1, K_lds, qr, r32, hi); MASK(pA0, pA1, j + 1);
    finishSM(pB0, pB1, alB, l_reg, pa0, pa1, pa2, pa3); SBAR();
    if (SDEPTH == 1 || j + 3 < NT) SLOAD(SE, (j + 1 + SDEPTH) * KVBLK); SBAR();
    pv_d0(o, vb0 + (int)SHM_V, pa0, pa1, pa2, pa3); partialSM(pA0, pA1, m_reg, mnA, alA);
    __syncthreads(); SWAIT(); SWRITE(1, SO);
    RESC(alA); __syncthreads();
  }
  SBAR(); qkt(pB0, pB1, (bf16_t*)((char*)K_lds + SHM_K), qr, r32, hi); MASK(pB0, pB1, NT - 1);
  finishSM(pA0, pA1, alA, l_reg, pa0, pa1, pa2, pa3); SBAR();
  pv_d0(o, vb0, pa0, pa1, pa2, pa3); partialSM(pB0, pB1, m_reg, mnB, alB);
  __syncthreads(); RESC(alB);
  finishSM(pB0, pB1, alB, l_reg, pa0, pa1, pa2, pa3); SBAR();
  pv_d0(o, vb0 + (int)SHM_V, pa0, pa1, pa2, pa3);
  if (hi == 0) li_l[r32] = l_reg; asm volatile("s_waitcnt lgkmcnt(0)" ::: "memory");
  if (BAND) { if (hi == 0) lse_out[(long)(wid * QBLK + r32) * ld_lse] = m_reg * SCALE + __logf(l_reg); }
  float rli[16];
#pragma unroll
  for (int r = 0; r < 16; ++r) rli[r] = __builtin_amdgcn_rcpf(li_l[crow(r, hi)]);
  bf16_t* Ow = Ob + (long)(wid * QBLK) * ldo;
#pragma unroll
  for (int r = 0; r < 16; ++r) { int orow = crow(r, hi);
    for (int d0 = 0; d0 < 4; ++d0) Ow[(long)orow * ldo + d0 * 32 + r32] = (bf16_t)(cvtpk(o[d0][r] * rli[r], 0.f) & 0xffffu); }
#undef SLOAD
#undef SWRITE
#undef SWAIT
#undef RESC
#undef MASK
}
#undef KSWZ
#undef SBAR
}

__device__ __forceinline__ void ph_attn_b(const Params& p, int layer, int bid, int nblk, char* lds) {
    const bf16_t* P = (const bf16_t*)(p.ws + WS_P); bf16_t* YB = (bf16_t*)(p.ws + WS_YA)  ;
    for (int u = bid; u < 512; u += nblk) {
        const int g = u & 3, qb = (u >> 2) & 15, kvh = (u >> 6) & 1, b = u >> 7, hq = kvh * 4 + g;
        const bf16_t* Qb = P + (size_t)(b * SEQ + qb * 256) * LDP + COL_BQ + hq * 128;
        const bf16_t* Kh = P + (size_t)(b * SEQ) * LDP + COL_BK + kvh * 128; const bf16_t* Vh = P + (size_t)(b * SEQ) * LDP + COL_BV + kvh * 128;
        att::attn_body<false, 2>(Qb, LDP, Kh, Vh, LDP, YB + (size_t)(b * SEQ + qb * 256) * YK + 768 + hq * 128, YK, nullptr, 0, 0, 0, SEQ / 64, lds);
    }
}
__device__ __forceinline__ void ph_attn_a(const Params& p, int layer, int bid, int nblk, char* lds) {
    const bf16_t* P = (const bf16_t*)(p.ws + WS_P);
    for (int u = bid; u < 1152; u += nblk) {
        const int sub = u % 48, bh = u / 48, h = bh % 6, b = bh / 6;
        int g, r, qb; if (sub < 16) { g = 0; r = 0; qb = sub; } else if (sub < 32) { g = 1; r = (sub - 16) >> 2; qb = (sub - 16) & 3; } else { g = 2; r = sub - 32; qb = 0; }
        const int d = g == 0 ? 1 : (g == 1 ? 4 : 16), L = SEQ / d, NT = L >= 384 ? 6 : 4, l0 = qb * 256;
        int kt0 = qb * 4 - 1; if (kt0 < 0) kt0 = 0; if (kt0 > L / 64 - NT) kt0 = L / 64 - NT;
        const size_t row0 = (size_t)(b * SEQ + l0 * d + r), rowk = (size_t)(b * SEQ + r);
        bf16_t* OA = (bf16_t*)(p.ws + WS_OA) + (size_t)g * MTOK * 768; float* LS = (float*)(p.ws + WS_LSE) + (size_t)g * MTOK * 6;
        att::attn_body<true, 1>(P + row0 * LDP + COL_AQ + h * 128, (long)d * LDP, P + rowk * LDP + COL_AK + h * 128, P + rowk * LDP + COL_AV + h * 128, (long)d * LDP,
                             OA + row0 * 768 + h * 128, (long)d * 768, LS + row0 * 6 + h, (long)d * 6, l0, kt0, NT, lds);
    }
}
struct AmIn { float l0, l1, l2; u32x4_t a, b, c; };
__device__ __forceinline__ void am_load(AmIn& x, const bf16_t* OA, const float* LS, int item) {
    const int row = item / 96, c8 = (item % 96) * 8, h = c8 >> 7;
    x.l0 = LS[(size_t)row * 6 + h]; x.l1 = LS[(size_t)MTOK * 6 + (size_t)row * 6 + h]; x.l2 = LS[(size_t)2 * MTOK * 6 + (size_t)row * 6 + h];
    x.a = *(const u32x4_t*)(OA + (size_t)row * 768 + c8); x.b = *(const u32x4_t*)(OA + (size_t)MTOK * 768 + (size_t)row * 768 + c8); x.c = *(const u32x4_t*)(OA + (size_t)2 * MTOK * 768 + (size_t)row * 768 + c8);
}
__device__ __forceinline__ void am_finish(const AmIn& x, bf16_t* YA, int item) {
    const int row = item / 96, c8 = (item % 96) * 8;
    const float mx = fmaxf(x.l0, fmaxf(x.l1, x.l2)); float w0 = __expf(x.l0 - mx), w1 = __expf(x.l1 - mx), w2 = __expf(x.l2 - mx); const float inv = __builtin_amdgcn_rcpf(w0 + w1 + w2); w0 *= inv; w1 *= inv; w2 *= inv;
    const u32x4_t a = x.a, bq = x.b, cq = x.c;
    u32x4_t w;
    w.x = pg8::cvt_pk_bf16(w0 * pg8::bf_lo(a.x) + w1 * pg8::bf_lo(bq.x) + w2 * pg8::bf_lo(cq.x), w0 * pg8::bf_hi(a.x) + w1 * pg8::bf_hi(bq.x) + w2 * pg8::bf_hi(cq.x));
    w.y = pg8::cvt_pk_bf16(w0 * pg8::bf_lo(a.y) + w1 * pg8::bf_lo(bq.y) + w2 * pg8::bf_lo(cq.y), w0 * pg8::bf_hi(a.y) + w1 * pg8::bf_hi(bq.y) + w2 * pg8::bf_hi(cq.y));
    w.z = pg8::cvt_pk_bf16(w0 * pg8::bf_lo(a.z) + w1 * pg8::bf_lo(bq.z) + w2 * pg8::bf_lo(cq.z), w0 * pg8::bf_hi(a.z) + w1 * pg8::bf_hi(bq.z) + w2 * pg8::bf_hi(cq.z));
    w.w = pg8::cvt_pk_bf16(w0 * pg8::bf_lo(a.w) + w1 * pg8::bf_lo(bq.w) + w2 * pg8::bf_lo(cq.w), w0 * pg8::bf_hi(a.w) + w1 * pg8::bf_hi(bq.w) + w2 * pg8::bf_hi(cq.w));
    *(u32x4_t*)(YA + (size_t)row * YK + c8) = w;
}
constexpr int AM_TILES = MTOK * 96 / 192;
__device__ __forceinline__ void amerge_wave_tile(const Params& p, int wt, int lane) {
    const bf16_t* OA = (const bf16_t*)(p.ws + WS_OA); const float* LS = (const float*)(p.ws + WS_LSE); bf16_t* YA = (bf16_t*)(p.ws + WS_YA);
    const int i0 = wt * 192 + lane;
    AmIn x0, x1, x2;
    am_load(x0, OA, LS, i0); am_load(x1, OA, LS, i0 + 64); am_load(x2, OA, LS, i0 + 128);
    am_finish(x0, YA, i0); am_finish(x1, YA, i0 + 64); am_finish(x2, YA, i0 + 128);
}

namespace ml {
using att::bf16x8; using att::f32x16; using att::u32x4; using att::cvtpk; using att::crow;
__device__ __forceinline__ float swap_add(float v) { auto rr = __builtin_amdgcn_permlane32_swap(__float_as_uint(v), __float_as_uint(v), false, false); return __uint_as_float(rr[0]) + __uint_as_float(rr[1]); }
__device__ __forceinline__ float from_lower(float v) { auto rr = __builtin_amdgcn_permlane32_swap(__float_as_uint(v), __float_as_uint(v), false, false); return __uint_as_float(rr[0]); }
__device__ __forceinline__ bf16x8 scale_frag(bf16x8 f, float s) {
    const u32x4 w = *reinterpret_cast<const u32x4*>(&f); u32x4 o;
    o.x = cvtpk(pg8::bf_lo(w.x) * s, pg8::bf_hi(w.x) * s); o.y = cvtpk(pg8::bf_lo(w.y) * s, pg8::bf_hi(w.y) * s);
    o.z = cvtpk(pg8::bf_lo(w.z) * s, pg8::bf_hi(w.z) * s); o.w = cvtpk(pg8::bf_lo(w.w) * s, pg8::bf_hi(w.w) * s);
    return *reinterpret_cast<const bf16x8*>(&o);
}
__device__ __forceinline__ bf16x8 weight_frag(bf16x8 f, f32x4_t wa, f32x4_t wb, float& acc) {
    const u32x4 w = *reinterpret_cast<const u32x4*>(&f);
    const float e0 = pg8::bf_lo(w.x) * wa[0], e1 = pg8::bf_hi(w.x) * wa[1], e2 = pg8::bf_lo(w.y) * wa[2], e3 = pg8::bf_hi(w.y) * wa[3];
    const float e4 = pg8::bf_lo(w.z) * wb[0], e5 = pg8::bf_hi(w.z) * wb[1], e6 = pg8::bf_lo(w.w) * wb[2], e7 = pg8::bf_hi(w.w) * wb[3];
    acc += ((e0 + e1) + (e2 + e3)) + ((e4 + e5) + (e6 + e7));
    u32x4 o; o.x = cvtpk(e0, e1); o.y = cvtpk(e2, e3); o.z = cvtpk(e4, e5); o.w = cvtpk(e6, e7);
    return *reinterpret_cast<const bf16x8*>(&o);
}
__device__ __forceinline__ bf16_t bf1(float v) { unsigned u = __float_as_uint(v); u += 0x7fffu + ((u >> 16) & 1u); return (bf16_t)(u >> 16); }

__device__ __forceinline__ void ph_ml_state(const Params& p, int bid, int nblk) {
    const int tid = tid_l(); const int wid = tid >> 6, lane = tid & 63, l32 = lane & 31, hi = lane >> 5;
    const bf16_t* Kt = (const bf16_t*)(p.ws + WS_KT); const bf16_t* Vt = (const bf16_t*)(p.ws + WS_VT);
    const float* gA = (const float*)(p.ws + WS_GA); const float* gM = (const float*)(p.ws + WS_GM);
    bf16_t* SB = (bf16_t*)(p.ws + WS_SBUF); bf16_t* NBf = (bf16_t*)(p.ws + WS_NBUF);
    for (int wu = bid * 8 + wid; wu < 2048; wu += nblk * 8) {
        const int pc = wu & 63, h = (wu >> 6) & 7, b = wu >> 9, bh = b * 8 + h, sqf = bh * 2, sqb = sqf + 1, cb = 63 - pc, pos0 = pc * 64;
        const float mend_f = gM[sqf * SEQ + pos0 + 63], mend_b = gM[sqb * SEQ + cb * 64 + 63];
        bf16x8 kwf[2][4], kwb[2][4]; float nf[2] = {0.f, 0.f}, nb[2] = {0.f, 0.f};
#pragma unroll
        for (int ks = 0; ks < 4; ++ks) {
            const int j0 = 16 * ks + 8 * hi;
            f32x4_t wfa = *(const f32x4_t*)(gA + sqf * SEQ + pos0 + j0), wfb = *(const f32x4_t*)(gA + sqf * SEQ + pos0 + j0 + 4);
            const float* gb = gA + sqb * SEQ + (SEQ - 1 - (pos0 + j0 + 7));
            const f32x4_t t0 = *(const f32x4_t*)(gb), t1 = *(const f32x4_t*)(gb + 4);
            f32x4_t wba = {t1[3], t1[2], t1[1], t1[0]}, wbb = {t0[3], t0[2], t0[1], t0[0]};
#pragma unroll
            for (int i = 0; i < 4; ++i) { wfa[i] = __expf(wfa[i] - mend_f); wfb[i] = __expf(wfb[i] - mend_f); wba[i] = __expf(wba[i] - mend_b); wbb[i] = __expf(wbb[i] - mend_b); }
#pragma unroll
            for (int dt = 0; dt < 2; ++dt) { const bf16x8 kf = *(const bf16x8*)(Kt + (size_t)(bh * 64 + dt * 32 + l32) * SEQ + pos0 + j0);
                kwf[dt][ks] = weight_frag(kf, wfa, wfb, nf[dt]); kwb[dt][ks] = weight_frag(kf, wba, wbb, nb[dt]); }
        }
#pragma unroll
        for (int dt = 0; dt < 2; ++dt) { const float a = swap_add(nf[dt]), c = swap_add(nb[dt]);
            if (hi == 0) { NBf[(size_t)(sqf * 64 + pc) * 64 + dt * 32 + l32] = bf1(a); NBf[(size_t)(sqb * 64 + cb) * 64 + dt * 32 + l32] = bf1(c); } }
#pragma unroll 1
        for (int vt = 0; vt < 4; ++vt) {
            f32x16 accf[2] = {}, accb[2] = {};
#pragma unroll
            for (int ks = 0; ks < 4; ++ks) { const bf16x8 vf = *(const bf16x8*)(Vt + (size_t)(bh * 128 + vt * 32 + l32) * SEQ + pos0 + 16 * ks + 8 * hi);
#pragma unroll
                for (int dt = 0; dt < 2; ++dt) { accf[dt] = __builtin_amdgcn_mfma_f32_32x32x16_bf16(vf, kwf[dt][ks], accf[dt], 0, 0, 0); accb[dt] = __builtin_amdgcn_mfma_f32_32x32x16_bf16(vf, kwb[dt][ks], accb[dt], 0, 0, 0); } }
            bf16_t* sf = SB + ((size_t)(sqf * 64 + pc) * 128 + vt * 32) * 64; bf16_t* sb = SB + ((size_t)(sqb * 64 + cb) * 128 + vt * 32) * 64;
#pragma unroll
            for (int dt = 0; dt < 2; ++dt)
#pragma unroll
                for (int r = 0; r < 16; ++r) { sf[crow(r, hi) * 64 + dt * 32 + l32] = bf1(accf[dt][r]); sb[crow(r, hi) * 64 + dt * 32 + l32] = bf1(accb[dt][r]); }
        }
    }
}

__device__ __forceinline__ void ph_ml_scan(const Params& p, int bid, int nblk) {
    const float* gM = (const float*)(p.ws + WS_GM);
    const int tid = tid_l();
    for (int item = bid * 512 + tid; item < 64 * 2064; item += nblk * 512) {
        const bool isS = item < 64 * 2048; const int sq = isS ? (item >> 11) : ((item - 64 * 2048) >> 4), e = isS ? (item & 2047) : ((item - 64 * 2048) & 15);
        bf16_t* base; size_t stride;
        if (isS) { base = (bf16_t*)(p.ws + WS_SBUF) + (size_t)sq * 64 * 8192 + e * 4; stride = 8192; } else { base = (bf16_t*)(p.ws + WS_NBUF) + (size_t)sq * 64 * 64 + e * 4; stride = 64; }
        float a0 = 0.f, a1 = 0.f, a2 = 0.f, a3 = 0.f, mprev = 0.f;
#pragma unroll 1
        for (int g = 0; g < 4; ++g) {
            u32x2_t buf[16]; float mend[16];
#pragma unroll
            for (int k = 0; k < 16; ++k) { buf[k] = *(const u32x2_t*)(base + (size_t)(g * 16 + k) * stride); mend[k] = gM[sq * SEQ + (g * 16 + k) * 64 + 63]; }
#pragma unroll
            for (int k = 0; k < 16; ++k) {
                const float dec = __expf(mprev - mend[k]); mprev = mend[k];
                u32x2_t o; o.x = pg8::cvt_pk_bf16(a0, a1); o.y = pg8::cvt_pk_bf16(a2, a3);
                *(u32x2_t*)(base + (size_t)(g * 16 + k) * stride) = o;
                a0 = dec * a0 + pg8::bf_lo(buf[k].x); a1 = dec * a1 + pg8::bf_hi(buf[k].x); a2 = dec * a2 + pg8::bf_lo(buf[k].y); a3 = dec * a3 + pg8::bf_hi(buf[k].y);
            }
        }
    }
}

constexpr int OUT_LDS_PER_WAVE = (128 + 32 * 65) * 4;
__device__ __forceinline__ void ph_ml_out(const Params& p, int layer, int bid, int nblk, char* lds) {
    const int tid = tid_l(); const int wid = tid >> 6, lane = tid & 63, l32 = lane & 31, hi = lane >> 5;
    float* af = (float*)(lds + wid * OUT_LDS_PER_WAVE); float* ab = af + 64; float* T = af + 128;
    const bf16_t* P = (const bf16_t*)(p.ws + WS_P); const bf16_t* cq = (const bf16_t*)(p.ws + WS_CQ); const bf16_t* ck = (const bf16_t*)(p.ws + WS_CK);
    const bf16_t* Vt = (const bf16_t*)(p.ws + WS_VT); const bf16_t* SB = (const bf16_t*)(p.ws + WS_SBUF); const bf16_t* NBf = (const bf16_t*)(p.ws + WS_NBUF);
    const float* gA = (const float*)(p.ws + WS_GA); const float* gM = (const float*)(p.ws + WS_GM); const float* gF = (const float*)(p.ws + WS_GF);
    bf16_t* YC = (bf16_t*)(p.ws + WS_YA) + 1792  ; const float* og = p.c_out_g + layer * 1024;
    for (int wu = bid * 8 + wid; wu < 4096; wu += nblk * 8) {
        const int th = wu & 1, pc = (wu >> 1) & 63, h = (wu >> 7) & 7, b = wu >> 10, bh = b * 8 + h, sqf = bh * 2, sqb = sqf + 1, cb = 63 - pc, pos0 = pc * 64;
        const size_t rowbase = (size_t)b * SEQ + pos0; const int t = th * 32 + l32;
        asm volatile("s_waitcnt lgkmcnt(0)" ::: "memory");
        af[lane] = gA[sqf * SEQ + pos0 + lane]; ab[lane] = gA[sqb * SEQ + (SEQ - 1 - (pos0 + lane))];
        const int idxb = SEQ - 1 - (pos0 + t);
        const float Mf = gM[sqf * SEQ + pos0 + t], Ff = gF[sqf * SEQ + pos0 + t], Mb = gM[sqb * SEQ + idxb], Fb = gF[sqb * SEQ + idxb];
        const float mpf = pc > 0 ? gM[sqf * SEQ + pos0 - 1] : 0.f, mpb = cb > 0 ? gM[sqb * SEQ + cb * 64 - 1] : 0.f;
        bf16x8 qf[4];
#pragma unroll
        for (int ks = 0; ks < 4; ++ks) qf[ks] = *(const bf16x8*)(cq + (rowbase + t) * 512 + h * 64 + 16 * ks + 8 * hi);
        f32x16 s0 = {}, s1 = {}, sn = {};
#pragma unroll
        for (int ks = 0; ks < 4; ++ks) {
            const bf16x8 k0 = *(const bf16x8*)(ck + (rowbase + l32) * 512 + h * 64 + 16 * ks + 8 * hi), k1 = *(const bf16x8*)(ck + (rowbase + 32 + l32) * 512 + h * 64 + 16 * ks + 8 * hi);
            bf16x8 nfr = {0, 0, 0, 0, 0, 0, 0, 0};
            if (l32 < 2) nfr = *(const bf16x8*)(NBf + (size_t)(l32 == 0 ? (sqf * 64 + pc) : (sqb * 64 + cb)) * 64 + 16 * ks + 8 * hi);
            s0 = __builtin_amdgcn_mfma_f32_32x32x16_bf16(k0, qf[ks], s0, 0, 0, 0); s1 = __builtin_amdgcn_mfma_f32_32x32x16_bf16(k1, qf[ks], s1, 0, 0, 0);
            sn = __builtin_amdgcn_mfma_f32_32x32x16_bf16(nfr, qf[ks], sn, 0, 0, 0);
        }
        const float qnf = from_lower(sn[0]), qnb = from_lower(sn[1]);
        asm volatile("s_waitcnt lgkmcnt(0)" ::: "memory");
        f32x16 b0, b1; float denf = 0.f, denb = 0.f; const float ninf = -__builtin_inff();
#pragma unroll
        for (int r = 0; r < 16; ++r) {
            const int sa = crow(r, hi), sb2 = 32 + crow(r, hi);
            const float ef0 = __expf(sa <= t ? af[sa] - Mf : ninf), eb0 = __expf(sa >= t ? ab[sa] - Mb : ninf);
            const float ef1 = __expf(sb2 <= t ? af[sb2] - Mf : ninf), eb1 = __expf(sb2 >= t ? ab[sb2] - Mb : ninf);
            b0[r] = eb0 * s0[r]; s0[r] = ef0 * s0[r]; b1[r] = eb1 * s1[r]; s1[r] = ef1 * s1[r];
            denf += s0[r] + s1[r]; denb += b0[r] + b1[r];
        }
        denf = swap_add(denf); denb = swap_add(denb);
        const float interf = __expf(mpf - Mf), interb = __expf(mpb - Mb);
        denf += interf * qnf; denb += interb * qnb;
        const float idf = __builtin_amdgcn_rcpf(fmaxf(fabsf(denf), __expf(-(Ff + Mf)))), idb = __builtin_amdgcn_rcpf(fmaxf(fabsf(denb), __expf(-(Fb + Mb))));
#pragma unroll
        for (int r = 0; r < 16; ++r) { s0[r] = s0[r] * idf + b0[r] * idb; s1[r] = s1[r] * idf + b1[r] * idb; }
        bf16x8 pa[4];
#define PK4(PV, BASE, OUT) do { unsigned a0_ = cvtpk(PV[BASE + 0], PV[BASE + 1]), a1_ = cvtpk(PV[BASE + 2], PV[BASE + 3]);   \
    unsigned b0_ = cvtpk(PV[BASE + 4], PV[BASE + 5]), b1_ = cvtpk(PV[BASE + 6], PV[BASE + 7]);                              \
    auto r0_ = __builtin_amdgcn_permlane32_swap(a0_, b0_, false, false); auto r1_ = __builtin_amdgcn_permlane32_swap(a1_, b1_, false, false); \
    u32x4 w_ = {r0_[0], r1_[0], r0_[1], r1_[1]}; OUT = *reinterpret_cast<bf16x8*>(&w_); } while (0)
        PK4(s0, 0, pa[0]); PK4(s0, 8, pa[1]); PK4(s1, 0, pa[2]); PK4(s1, 8, pa[3]);
#undef PK4
        bf16x8 qef[4], qeb[4];
#pragma unroll
        for (int ks = 0; ks < 4; ++ks) { qef[ks] = scale_frag(qf[ks], interf * idf); qeb[ks] = scale_frag(qf[ks], interb * idb); }
        f32x16 o[4] = {};
#pragma unroll
        for (int vt = 0; vt < 4; ++vt) {
#pragma unroll
            for (int ks = 0; ks < 4; ++ks) {
                const bf16x8 vf = *(const bf16x8*)(Vt + (size_t)(bh * 128 + vt * 32 + l32) * SEQ + pos0 + 16 * ks + 8 * hi);
                const bf16x8 cf = *(const bf16x8*)(SB + ((size_t)(sqf * 64 + pc) * 128 + vt * 32 + l32) * 64 + 16 * ks + 8 * hi);
                const bf16x8 cbf = *(const bf16x8*)(SB + ((size_t)(sqb * 64 + cb) * 128 + vt * 32 + l32) * 64 + 16 * ks + 8 * hi);
                o[vt] = __builtin_amdgcn_mfma_f32_32x32x16_bf16(vf, pa[ks], o[vt], 0, 0, 0);
                o[vt] = __builtin_amdgcn_mfma_f32_32x32x16_bf16(cf, qef[ks], o[vt], 0, 0, 0);
                o[vt] = __builtin_amdgcn_mfma_f32_32x32x16_bf16(cbf, qeb[ks], o[vt], 0, 0, 0);
            }
        }
        float ss = 0.f;
#pragma unroll
        for (int vt = 0; vt < 4; ++vt)
#pragma unroll
            for (int r = 0; r < 16; ++r) ss += o[vt][r] * o[vt][r];
        ss = swap_add(ss);
        const float rs = rsqrtf(ss * (1.0f / 128.0f) + EPS);
#pragma unroll
        for (int half = 0; half < 2; ++half) {
            asm volatile("s_waitcnt lgkmcnt(0)" ::: "memory");
#pragma unroll
            for (int v2 = 0; v2 < 2; ++v2)
#pragma unroll
                for (int r = 0; r < 16; ++r) T[l32 * 65 + v2 * 32 + crow(r, hi)] = o[half * 2 + v2][r] * rs;
            asm volatile("s_waitcnt lgkmcnt(0)" ::: "memory");
#pragma unroll
            for (int it = 0; it < 4; ++it) {
                const int item = it * 64 + lane, row = item >> 3, vg = (item & 7) * 8, vcol = h * 128 + half * 64 + vg; const size_t grow = rowbase + th * 32 + row;
                const f32x4_t g0 = *(const f32x4_t*)(og + vcol), g1 = *(const f32x4_t*)(og + vcol + 4);
                const u32x4_t op = *(const u32x4_t*)(P + grow * LDP + COL_CO + vcol);
                float x[8];
#pragma unroll
                for (int i = 0; i < 8; ++i) x[i] = T[row * 65 + vg + i];
                x[0] *= g0[0] * pg8::sigmoidf_(pg8::bf_lo(op.x)); x[1] *= g0[1] * pg8::sigmoidf_(pg8::bf_hi(op.x)); x[2] *= g0[2] * pg8::sigmoidf_(pg8::bf_lo(op.y)); x[3] *= g0[3] * pg8::sigmoidf_(pg8::bf_hi(op.y));
                x[4] *= g1[0] * pg8::sigmoidf_(pg8::bf_lo(op.z)); x[5] *= g1[1] * pg8::sigmoidf_(pg8::bf_hi(op.z)); x[6] *= g1[2] * pg8::sigmoidf_(pg8::bf_lo(op.w)); x[7] *= g1[3] * pg8::sigmoidf_(pg8::bf_hi(op.w));
                u32x4_t w; w.x = pg8::cvt_pk_bf16(x[0], x[1]); w.y = pg8::cvt_pk_bf16(x[2], x[3]); w.z = pg8::cvt_pk_bf16(x[4], x[5]); w.w = pg8::cvt_pk_bf16(x[6], x[7]);
                *(u32x4_t*)(YC + grow * YK + vcol) = w;
            }
        }
    }
}
}
__device__ __forceinline__ void cvt_catch_up(const Params& p, int limit, volatile LAS unsigned* st, int nwaves) {
    const int tid = tid_l(); const int wid = tid >> 6, lane = tid & 63;
    unsigned cur = st[8 + wid];
    for (; cur < (unsigned)limit; cur += (unsigned)nwaves) cvt_wave_tile(p, (int)cur, lane);
    st[8 + wid] = cur;
}
__device__ __forceinline__ void convq_catch_up(const Params& p, int layer, volatile LAS unsigned* st, int nwaves) {
    const int tid = tid_l(); const int wid = tid >> 6, lane = tid & 63;
    unsigned dq = st[16 + wid];
    for (; dq < 2048u; dq += (unsigned)nwaves) conv_wave_item(p, layer, (int)dq, lane);
    st[16 + wid] = dq;
}
__device__ __forceinline__ void amerge_catch_up(const Params& p, volatile LAS unsigned* st, int nwaves) {
    const int tid = tid_l(); const int wid = tid >> 6, lane = tid & 63;
    unsigned dm = st[24 + wid];
    for (; dm < (unsigned)AM_TILES; dm += (unsigned)nwaves) amerge_wave_tile(p, (int)dm, lane);
    st[24 + wid] = dm;
}
template <int MODE>
__device__ __forceinline__ void grid_barrier(unsigned char* wsp, volatile LAS unsigned* st, const Params& p, int limit  , int nwaves, int layer = 0) {
    asm volatile("" : "+s"(wsp));
    unsigned* bar = (unsigned*)(wsp + WS_CTRL); const unsigned x = xb_xcc_id();
    asm volatile("s_waitcnt vmcnt(0)" ::: "memory");
    __syncthreads();
    if (threadIdx.x == 0) {
        __builtin_amdgcn_s_waitcnt(0);
        unsigned nloc = st[0], nx = st[1];
        if (nloc == 0u) { xcd_barrier_complete(bar, x, nloc, nx); st[0] = nloc; st[1] = nx; }
        const unsigned old = xb_add(&bar[XB_XSUB(x)], 1u);
        const unsigned gen = old / nloc;
        if (old + 1u == (gen + 1u) * nloc) {
            __builtin_amdgcn_fence(__ATOMIC_RELEASE, "agent");
            asm volatile("s_waitcnt vmcnt(0)" ::: "memory");
            const unsigned og = xb_add(&bar[XB_TOP], 1u);
            const unsigned tg = og / nx;
            if (og + 1u == (tg + 1u) * nx) xb_add(&bar[XB_TOPGEN], 1u);
            else XB_SPIN(xb_ld(&bar[XB_TOPGEN]) == tg, bar);
            __builtin_amdgcn_fence(__ATOMIC_ACQUIRE, "agent");
            xb_add(&bar[XB_XGEN(x)], 1u);
            asm volatile("s_waitcnt vmcnt(0)" ::: "memory");
            st[2] = 0u;
        } else { st[2] = 1u; st[3] = gen; }
    }
    __syncthreads();
    if (st[2] != 0u) {
        const int tid = tid_l(); const int wid = tid >> 6, lane = tid & 63;
        if (wid == 0) {
            if (lane == 0) { const unsigned gen = st[3];
                XB_SPIN(xb_ld(&bar[XB_XGEN(x)]) == gen, bar);
                __builtin_amdgcn_fence(__ATOMIC_ACQUIRE, "agent");
                asm volatile("s_waitcnt vmcnt(0)" ::: "memory");
                st[2] = 2u; }
        } else {
            unsigned cur = st[8 + wid], dq = MODE == 1 ? st[16 + wid] : 0u, dm = MODE == 2 ? st[24 + wid] : 0u;
            while (st[2] != 2u) {
                if (MODE == 1 && dq < 2048u) { conv_wave_item(p, layer, (int)dq, lane); dq += (unsigned)nwaves; }
                else if (MODE == 2 && dm < (unsigned)AM_TILES) { amerge_wave_tile(p, (int)dm, lane); dm += (unsigned)nwaves; }
                else if (cur < (unsigned)limit) { cvt_wave_tile(p, (int)cur, lane); cur += (unsigned)nwaves; }
                else __builtin_amdgcn_s_sleep(8);
            }
            st[8 + wid] = cur; if (MODE == 1) st[16 + wid] = dq; if (MODE == 2) st[24 + wid] = dm;
        }
    }
    __syncthreads();
}
constexpr int RS_UNITS = 16;
constexpr int MEGA_LDS = pg8::STAGE_BYTES + 128 + RS_UNITS * 256 * 4;
template <class Sched>
__device__ __forceinline__ void rs_prefill(const Sched& S, const unsigned long long* stats, PG8_LAS float* rsl) {
    const int tid = tid_l();
    constexpr int NK = RS_UNITS * 256 / 512;
    unsigned long long v[NK]; bool ok[NK];
#pragma unroll
    for (int k = 0; k < NK; ++k) {
        const int j = tid + 512 * k, i = j >> 8; pg8::Unit u; u.pm = 0; u.pn = 0;
        ok[k] = i < RS_UNITS && S.next(i, u);
        v[k] = __hip_atomic_load(stats + (size_t)(ok[k] ? u.pm : 0) * 256 + (j & 255), __ATOMIC_RELAXED, __HIP_MEMORY_SCOPE_AGENT);
    }
#pragma unroll
    for (int k = 0; k < NK; ++k) if (ok[k]) rsl[tid + 512 * k] = rsqrtf((float)v[k] * (1.0f / (pg8::SS_SCALE * 2048.0f)) + 1e-6f);
    __syncthreads();
}
#ifndef WGM_INPROJ
#define WGM_INPROJ 4
#endif
#ifndef WGM_UP
#define WGM_UP 4
#endif
#ifndef WGM_N8
#define WGM_N8 4
#endif
__global__ __launch_bounds__(512, 2) void k_mega(Params p) {
    extern __shared__ __attribute__((aligned(16))) unsigned char shm[];
    const int bid = blockIdx.x, nblk = gridDim.x;
    volatile LAS unsigned* xw = (volatile LAS unsigned*)(shm + pg8::STAGE_BYTES);
    if (threadIdx.x < 8) xw[threadIdx.x] = 0u;
    if (threadIdx.x < 8) xw[8 + threadIdx.x] = (unsigned)(CVT_TPL + bid * 8 + threadIdx.x);
    __syncthreads();
    (void)xcd_barrier_post((unsigned*)(p.ws + WS_CTRL), xw);
    unsigned char* ws = p.ws;
    bf16_t* XN = (bf16_t*)(ws + WS_XN); unsigned long long* ST = (unsigned long long*)(ws + WS_STATS); unsigned long long* STB = ST + MTOK; bf16_t* P = (bf16_t*)(ws + WS_P); float* GT = (float*)(ws + WS_GATES);
    bf16_t* YA = (bf16_t*)(ws + WS_YA);
    bf16_t* MG = (bf16_t*)(ws + WS_MERGED); bf16_t* U = (bf16_t*)(ws + WS_P);
    PG8_LAS unsigned char* glds = (PG8_LAS unsigned char*)shm;
    { const int tid = tid_l(); for (int it = bid * 8 + (tid >> 6); it < CVT_TPL; it += nblk * 8) cvt_wave_tile(p, it, tid & 63); }
    ph_tables(p, bid, nblk);
    ph_xprep(p.x, XN, ST, bid, nblk);
    grid_barrier<0>(p.ws, xw, p, 2 * CVT_TPL, nblk * 8);
#pragma unroll 1
    for (int l = 0; l < DEPTH; ++l) {
        const int lim = (l + 2 < DEPTH ? l + 2 : DEPTH) * CVT_TPL;
        if ((threadIdx.x & 63) == 0) { xw[16 + (threadIdx.x >> 6)] = (unsigned)(bid * 8 + (threadIdx.x >> 6)); xw[24 + (threadIdx.x >> 6)] = (unsigned)(bid * 8 + (threadIdx.x >> 6)); }
        { pg8::Gemm g{XN, (const bf16_t*)(ws + WS_WT_IN + l * SZ_WT_IN), MTOK, LDP, DM, 0}; pg8::EpiInProj E{P, GT, (const PG8_LAS float*)(glds + pg8::STAGE_BYTES + 128), LDP, 27, 51, 0};
          pg8::StaticOrder S; S.init(g.M, g.N, nblk, bid, WGM_INPROJ); rs_prefill(S, ST, (PG8_LAS float*)(glds + pg8::STAGE_BYTES + 128)); pg8::gemm_phase<pg8::EpiInProj, pg8::StaticOrder, true, true, true, true>(glds, g, S, E); }
        grid_barrier<0>(p.ws, xw, p, lim, nblk * 8);
        ph_thin(p, l, bid, nblk, (char*)shm);
        ph_gatescan(p, l, bid, nblk, (char*)shm);
        grid_barrier<1>(p.ws, xw, p, lim, nblk * 8, l);
        ph_attn_b(p, l, bid, nblk, (char*)shm);
        ph_attn_a(p, l, bid, nblk, (char*)shm);
        ml::ph_ml_state(p, bid, nblk);
        grid_barrier<1>(p.ws, xw, p, lim, nblk * 8, l);
        ml::ph_ml_scan(p, bid, nblk);
        convq_catch_up(p, l, xw, nblk * 8);
        grid_barrier<2>(p.ws, xw, p, lim, nblk * 8, l);
        ml::ph_ml_out(p, l, bid, nblk, (char*)shm);
        amerge_catch_up(p, xw, nblk * 8);
        grid_barrier<0>(p.ws, xw, p, lim, nblk * 8);
        { pg8::Gemm g{YA, (const bf16_t*)(ws + WS_WT_A + l * SZ_WT_CAT), MTOK, DM, YK, 0}; pg8::EpiBranchCat E{P + COL_G, MG, LDP, DM};
          pg8::StaticOrder S; S.init(g.M, g.N, nblk, bid, WGM_N8); pg8::gemm_phase<pg8::EpiBranchCat, pg8::StaticOrder, true, true, false>(glds, g, S, E); }
        grid_barrier<0>(p.ws, xw, p, lim, nblk * 8);
        { pg8::Gemm g{MG, (const bf16_t*)(ws + WS_WT_OUT + l * SZ_WT_OUT), MTOK, DM, DM, 0}; pg8::EpiResid E{XN, p.out, STB, DM, 0};
          pg8::StaticOrder S; S.init(g.M, g.N, nblk, bid, WGM_N8); pg8::gemm_phase<pg8::EpiResid, pg8::StaticOrder, true, true, false>(glds, g, S, E); }
        grid_barrier<0>(p.ws, xw, p, lim, nblk * 8);
        { pg8::Gemm g{XN, (const bf16_t*)(ws + WS_WT_UP + l * SZ_WT_UP), MTOK, DFF, DM, 0}; pg8::EpiRelu2 E{U, (const PG8_LAS float*)(glds + pg8::STAGE_BYTES + 128), DFF, 0};
          pg8::StaticOrder S; S.init(g.M, g.N, nblk, bid, WGM_UP); rs_prefill(S, STB, (PG8_LAS float*)(glds + pg8::STAGE_BYTES + 128)); pg8::gemm_phase<pg8::EpiRelu2, pg8::StaticOrder, true, true, true, true>(glds, g, S, E); }
        grid_barrier<0>(p.ws, xw, p, lim, nblk * 8);
        { pg8::Gemm g{U, (const bf16_t*)(ws + WS_WT_DOWN + l * SZ_WT_UP), MTOK, DM, DFF, 0}; pg8::EpiResid E{XN, p.out, ST, DM, l == DEPTH - 1 ? 1 : 0};
          pg8::StaticOrder S; S.init(g.M, g.N, nblk, bid, WGM_N8); pg8::gemm_phase<pg8::EpiResid, pg8::StaticOrder, true, true, true>(glds, g, S, E); }
        if (l + 1 < DEPTH) {
            cvt_catch_up(p, lim, xw, nblk * 8);
            grid_barrier<0>(p.ws, xw, p, lim, nblk * 8);
        }
    }
}

extern "C" void kernel_launch(void* const* d_in, const int* in_sizes, int n_in, void* d_out, int out_size, void* d_ws, size_t ws_size, hipStream_t stream) {
    if (n_in != 18 || out_size != MTOK * DM || ws_size < WS_END) { fprintf(stderr, "kernel_launch: bad shapes n_in %d out %d ws %zu (need %zu)\n", n_in, out_size, ws_size, (size_t)WS_END); return; }
    Params p{};
    p.x = (const float*)d_in[0]; p.norm1_g = (const float*)d_in[1]; p.w_in = (const float*)d_in[2]; p.a_q_gain = (const float*)d_in[3]; p.a_k_gain = (const float*)d_in[4];
    p.b_q_gain = (const float*)d_in[5]; p.b_k_gain = (const float*)d_in[6]; p.c_conv_w = (const float*)d_in[7]; p.c_conv_b = (const float*)d_in[8]; p.c_gate_b = (const float*)d_in[9];
    p.c_out_g = (const float*)d_in[10]; p.w_a = (const float*)d_in[11]; p.w_b = (const float*)d_in[12]; p.w_c = (const float*)d_in[13]; p.w_out = (const float*)d_in[14];
    p.norm2_g = (const float*)d_in[15]; p.w_up = (const float*)d_in[16]; p.w_down = (const float*)d_in[17]; p.out = (float*)d_out; p.ws = (unsigned char*)d_ws;
    static int grid = 0;
    if (!grid) {
        int dev = 0, cus = 0, per_cu = 0;
        (void)hipGetDevice(&dev); (void)hipDeviceGetAttribute(&cus, hipDeviceAttributeMultiprocessorCount, dev);
        (void)hipFuncSetAttribute((const void*)k_mega, hipFuncAttributeMaxDynamicSharedMemorySize, MEGA_LDS);
        (void)hipOccupancyMaxActiveBlocksPerMultiprocessor(&per_cu, k_mega, 512, MEGA_LDS);
        if (per_cu < 1 || cus < 1) { fprintf(stderr, "kernel_launch: occupancy query says %d blocks/CU on %d CUs\n", per_cu, cus); return; }
        grid = cus;
        if ((MTOK / 256) * (LDP / 256) > RS_UNITS * cus) { fprintf(stderr, "kernel_launch: %d CUs are too few for the rstd table (%d units per workgroup)\n", cus, RS_UNITS); grid = 0; return; }
    }
    (void)hipMemsetAsync(d_ws, 0, XCD_BAR_WORDS * sizeof(unsigned), stream);
    hipLaunchKernelGGL(k_mega, dim3(grid), dim3(512), MEGA_LDS, stream, p);
    const hipError_t le = hipPeekAtLastError();
    if (le != hipSuccess) fprintf(stderr, "kernel_launch: launch failed: %s\n", hipGetErrorName(le));
}
```
